# Optimizing an MI355X kernel written in HIP

```python
import jax, jax.numpy as jnp
from jax import lax
import numpy as np

D_MODEL = 2048
BATCH = 2
SEQ = 4096
DEPTH = 2

N_MIXERS = 2
N_A = (DEPTH + 1) // 2
N_B = DEPTH // 2
MEM_LEN = 256
MIX_W = D_MODEL
TOK_W = 3 * D_MODEL // 4
X_HEADS = 4
X_HEAD_DIM = (MIX_W - TOK_W) // X_HEADS
X_W = X_HEADS * X_HEAD_DIM
GLA_HEADS = 4
GLA_DV = TOK_W // GLA_HEADS
GLA_DK = GLA_DV // 2
GLA_KW = GLA_HEADS * GLA_DK
GLA_RANK = 16
GLA_TAU = 16.0
GLA_CHUNK = 64
GLA_IN = 2 * GLA_KW + 2 * TOK_W + GLA_RANK + X_W
GLA_SPLITS = (GLA_KW, 2 * GLA_KW, 2 * GLA_KW + TOK_W, 2 * GLA_KW + 2 * TOK_W, 2 * GLA_KW + 2 * TOK_W + GLA_RANK)
CONV_GROUPS = 4
CONV_W = TOK_W
CONV_K = 3
CONV_IN = 3 * CONV_W + X_W
CONV_SPLITS = (CONV_W, 2 * CONV_W, 3 * CONV_W)
D_FF = ((8 * D_MODEL // 3 + 255) // 256) * 256
EPS = 1e-6

kernel_name = "hybrid_gla_shortconv_macaron_memxattn"


def rmsnorm(x, g):
    x32 = x.astype(jnp.float32)
    y = x32 * lax.rsqrt(jnp.mean(x32 * x32, axis=-1, keepdims=True) + EPS)
    return (y * g.astype(jnp.float32)).astype(x.dtype)


def swiglu(x, w_in, w_out):
    gate, up = jnp.split(x @ w_in, 2, axis=-1)
    return (jax.nn.silu(gate) * up) @ w_out


def memory_attention(q, mem_n, w_mem_kv):
    b, s, _ = q.shape
    k, v = jnp.split(mem_n @ w_mem_kv, 2, axis=-1)
    q = q.reshape(b, s, X_HEADS, X_HEAD_DIM)
    k = k.reshape(b, -1, X_HEADS, X_HEAD_DIM)
    v = v.reshape(b, -1, X_HEADS, X_HEAD_DIM)
    scores = jnp.einsum('bshd,bmhd->bhsm', q, k).astype(jnp.float32) * (X_HEAD_DIM ** -0.5)
    p = jax.nn.softmax(scores, axis=-1).astype(v.dtype)
    o = jnp.einsum('bhsm,bmhd->bshd', p, v)
    return o.reshape(b, s, X_W)


def gla_attention(q, k, v, log_a):
    b, s, h, dk = q.shape
    dv = v.shape[-1]
    n = s // GLA_CHUNK

    def to_chunks(t):
        return t.reshape(b, n, GLA_CHUNK, h, t.shape[-1]).transpose(1, 0, 3, 2, 4)

    causal = jnp.tril(jnp.ones((GLA_CHUNK, GLA_CHUNK), dtype=bool))[:, :, None]

    def step(state, inp):
        qc, kc, vc, gc = inp
        cum = jnp.cumsum(gc, axis=2)
        o_inter = jnp.einsum('bhtk,bhkv->bhtv', qc * jnp.exp(cum), state)
        diff = cum[:, :, :, None, :] - cum[:, :, None, :, :]
        decay = jnp.exp(jnp.where(causal, diff, -jnp.inf))
        attn = jnp.einsum('bhtsk,bhsk->bhts', qc[:, :, :, None, :] * decay, kc)
        o_intra = jnp.einsum('bhts,bhsv->bhtv', attn, vc)
        last = cum[:, :, -1:, :]
        state = (jnp.exp(last[:, :, 0, :])[..., None] * state
                 + jnp.einsum('bhsk,bhsv->bhkv', kc * jnp.exp(last - cum), vc))
        return state, o_inter + o_intra

    s0 = jnp.zeros((b, h, dk, dv), jnp.float32)
    _, o = lax.scan(step, s0, (to_chunks(q), to_chunks(k), to_chunks(v), to_chunks(log_a)))
    return o.transpose(1, 0, 3, 2, 4).reshape(b, s, h, dv)


def gla_mixer(h, w_in, gate_w2, gate_b, head_g):
    b, s, _ = h.shape
    q, k, v, r, g_low, xq = jnp.split(h @ w_in, GLA_SPLITS, axis=-1)
    z = (g_low @ gate_w2 + gate_b).astype(jnp.float32)
    log_a = (jax.nn.log_sigmoid(z) / GLA_TAU).reshape(b, s, GLA_HEADS, GLA_DK)
    q = q.reshape(b, s, GLA_HEADS, GLA_DK).astype(jnp.float32) * (GLA_DK ** -0.5)
    k = k.reshape(b, s, GLA_HEADS, GLA_DK).astype(jnp.float32)
    v = v.reshape(b, s, GLA_HEADS, GLA_DV).astype(jnp.float32)
    o = gla_attention(q, k, v, log_a)
    o = rmsnorm(o, head_g).astype(h.dtype).reshape(b, s, TOK_W)
    return o * jax.nn.silu(r), xq


def conv_mixer(h, w_in, conv_w, conv_b):
    b_gate, c_gate, xt, xq = jnp.split(h @ w_in, CONV_SPLITS, axis=-1)
    u = c_gate * xt
    y = lax.conv_general_dilated(u, conv_w[:, None, :], window_strides=(1,),
                                 padding=[(CONV_K - 1, 0)],
                                 dimension_numbers=('NWC', 'WIO', 'NWC'),
                                 feature_group_count=CONV_W) + conv_b
    return b_gate * y, xq


def setup_inputs(seed: int = 0) -> dict:
    key = jax.random.key(seed)
    ks = jax.random.split(key, 20)

    def nrm(k, shape, scale):
        return jax.random.normal(k, shape, jnp.float32) * scale

    def gain(k, shape):
        return 1.0 + 0.02 * jax.random.normal(k, shape, jnp.float32)

    return {
        "x": nrm(ks[0], (BATCH, SEQ, D_MODEL), 1.0),
        "mem": nrm(ks[1], (BATCH, MEM_LEN, D_MODEL), 1.0),
        "ffn_pre_g": gain(ks[2], (DEPTH, 2, D_MODEL)),
        "ffn_w_in": nrm(ks[3], (DEPTH, 2, D_MODEL, 2 * D_FF), D_MODEL ** -0.5),
        "ffn_w_out": nrm(ks[4], (DEPTH, 2, D_FF, D_MODEL), D_FF ** -0.5),
        "ffn_post_g": gain(ks[5], (DEPTH, 2, D_MODEL)),
        "mix_pre_g": gain(ks[6], (DEPTH, D_MODEL)),
        "mix_post_g": gain(ks[7], (DEPTH, D_MODEL)),
        "mem_g": gain(ks[8], (DEPTH, D_MODEL)),
        "w_mem_kv": nrm(ks[9], (DEPTH, D_MODEL, 2 * X_W), D_MODEL ** -0.5),
        "w_mix_out": nrm(ks[10], (DEPTH, MIX_W, D_MODEL), MIX_W ** -0.5),
        "gla_w_in": nrm(ks[11], (N_A, D_MODEL, GLA_IN), D_MODEL ** -0.5),
        "gla_gate_w2": nrm(ks[12], (N_A, GLA_RANK, GLA_KW), GLA_RANK ** -0.5),
        "gla_gate_b": nrm(ks[13], (N_A, GLA_KW), 0.1),
        "gla_head_g": gain(ks[14], (N_A, GLA_DV)),
        "conv_w_in": nrm(ks[15], (N_B, D_MODEL, CONV_IN), D_MODEL ** -0.5),
        "conv_w": nrm(ks[16], (N_B, CONV_K, CONV_W), CONV_K ** -0.5),
        "conv_b": nrm(ks[17], (N_B, CONV_W), 0.02),
    }


def reference(x, mem, ffn_pre_g, ffn_w_in, ffn_w_out, ffn_post_g, mix_pre_g, mix_post_g,
              mem_g, w_mem_kv, w_mix_out, gla_w_in, gla_gate_w2, gla_gate_b, gla_head_g,
              conv_w_in, conv_w, conv_b):
    for i in range(DEPTH):
        x = x + 0.5 * rmsnorm(swiglu(rmsnorm(x, ffn_pre_g[i, 0]), ffn_w_in[i, 0], ffn_w_out[i, 0]),
                              ffn_post_g[i, 0])
        hn = rmsnorm(x, mix_pre_g[i])
        j = i // N_MIXERS
        if i % N_MIXERS == 0:
            tok, xq = gla_mixer(hn, gla_w_in[j], gla_gate_w2[j], gla_gate_b[j], gla_head_g[j])
        else:
            tok, xq = conv_mixer(hn, conv_w_in[j], conv_w[j], conv_b[j])
        xo = memory_attention(xq, rmsnorm(mem, mem_g[i]), w_mem_kv[i])
        mixed = jnp.concatenate([tok, xo], axis=-1) @ w_mix_out[i]
        x = x + rmsnorm(mixed, mix_post_g[i])
        x = x + 0.5 * rmsnorm(swiglu(rmsnorm(x, ffn_pre_g[i, 1]), ffn_w_in[i, 1], ffn_w_out[i, 1]),
                              ffn_post_g[i, 1])
    return x
```

```cpp
#include <hip/hip_runtime.h>
#include <hip/hip_cooperative_groups.h>
#include <cstdio>
#include <cstdint>
namespace cg = cooperative_groups;
namespace pg8 {
#define PG8_LAS __attribute__((address_space(3)))
typedef unsigned short bf16_t;
typedef short bf16x8 __attribute__((ext_vector_type(8)));
typedef float f32x4 __attribute__((ext_vector_type(4)));
typedef unsigned u32x4 __attribute__((ext_vector_type(4)));
constexpr int BM = 256, BK = 64, HALF = 128, HTB = HALF * BK * 2  , STAGE_BYTES = 8 * HTB, NXCD = 8, WGM = 8;

__host__ __device__ __forceinline__ int lds_byte(int r, int c) { const int st = (r >> 4) * 2 + (c >> 5), rr = r & 15, cc = c & 31, ob = rr * 64 + cc * 2; return st * 1024 + (ob ^ (((ob >> 9) & 1) << 5)); }
__host__ __device__ __forceinline__ void stage_rc(int b, int& R, int& C) { const int st = b / 1024, sb = b % 1024, swz = sb ^ (((sb >> 9) & 1) << 5); R = (st >> 1) * 16 + swz / 64; C = (st & 1) * 32 + (swz % 64) / 2; }
__host__ __device__ __forceinline__ int perm32(int rho) { const int n = rho >> 4, i = rho & 15; return 8 * (i >> 2) + 4 * n + (i & 3); }

struct Unit { int pm, pn; };
struct Gemm { const bf16_t* A; const bf16_t* Bt; int M, N, K; };

struct StaticOrder {
    int nM, nN, nwg, G, c;
    __host__ __device__ void init(int M, int N, int G_, int c_) { nM = M / BM; nN = N / BM; nwg = nM * nN; G = G_; c = c_; }
    __host__ __device__ bool next(int i, Unit& u) const {
        const long L = (long)i * G + c; if (L >= nwg) return false;
        int wgid = (int)L; { const int q = nwg / NXCD, r = nwg % NXCD, xcd = wgid % NXCD, off = wgid / NXCD; wgid = (xcd < r ? xcd * (q + 1) : r * (q + 1) + (xcd - r) * q) + off; }
        const int nig = WGM * nN, gid = wgid / nig, fm = gid * WGM, gsz = (nM - fm) < WGM ? (nM - fm) : WGM;
        u.pm = fm + ((wgid % nig) % gsz); u.pn = (wgid % nig) / gsz; return true;
    }
    __device__ __forceinline__ void a_ready(const Unit&) const {}
    __device__ __forceinline__ void done(const Unit&) const {}
};

typedef float f32x2_t __attribute__((ext_vector_type(2))); typedef __bf16 bf16x2_t __attribute__((ext_vector_type(2)));
__device__ __forceinline__ unsigned cvt_pk_bf16(float lo, float hi) { f32x2_t v = {lo, hi}; bf16x2_t b = __builtin_convertvector(v, bf16x2_t); return __builtin_bit_cast(unsigned, b); }

template <class Epi, class Sched, bool ALIGN_EPI = false, bool SP2 = false>
__device__ __forceinline__ void gemm_phase(PG8_LAS unsigned char* lds, const Gemm g, const Sched& S, const Epi& E) {
    int tid_ = threadIdx.x; asm volatile("" : "+v"(tid_));
    const int tid = tid_, wid = __builtin_amdgcn_readfirstlane(tid >> 6), lane = tid & 63, wr = wid >> 2, wc = wid & 3, fr = lane & 15, fq = lane >> 4;
    const int K = g.K, nt = K / BK;
    unsigned voffA[2], voffB[2];
#pragma unroll
    for (int i = 0; i < 2; ++i) { int R, C; stage_rc(tid * 16 + i * 8192, R, C); const int Rb = Epi::PERM ? ((R & ~31) + perm32(R & 31)) : R;
        voffA[i] = (unsigned)(R * K + C) * 2u; voffB[i] = (unsigned)(Rb * K + C) * 2u; }
    const size_t kstep = (size_t)(BK * 2);
    const size_t hstep = (size_t)HALF * K * 2;
    const size_t tstep = 2 * hstep;
    const unsigned ldsw = (unsigned)wid * 1024u;
    const int aoff = lds_byte(wr * 64 + fr, fq * 8), boff = lds_byte(wc * 32 + fr, fq * 8);
#define PG8_SA(b, h) (((b) * 2 + (h)) * HTB)
#define PG8_SB(b, h) ((4 + (b) * 2 + (h)) * HTB)
#define PG8_STAGE(bufoff, gbase, voff) do { _Pragma("unroll") for (int _i = 0; _i < 2; ++_i) \
        __builtin_amdgcn_global_load_lds((const unsigned*)((const char*)(gbase) + (voff)[_i]), (PG8_LAS unsigned*)(lds + (bufoff) + ldsw + _i * 8192), 16, 0, 0); } while (0)
#define PG8_LDA(dst, b, h) do { _Pragma("unroll") for (int m = 0; m < 4; ++m) _Pragma("unroll") for (int k = 0; k < 2; ++k) dst[m][k] = *(const PG8_LAS bf16x8*)(lds + PG8_SA(b, h) + aoff + m * 2048 + k * 1024); } while (0)
#define PG8_LDB(dst, b, h) do { _Pragma("unroll") for (int n = 0; n < 2; ++n) _Pragma("unroll") for (int k = 0; k < 2; ++k) dst[n][k] = *(const PG8_LAS bf16x8*)(lds + PG8_SB(b, h) + boff + n * 2048 + k * 1024); } while (0)
#define PG8_MMA(ai, bj, At, Bt) do { __builtin_amdgcn_s_setprio(1); _Pragma("unroll") for (int m = 0; m < 4; ++m) _Pragma("unroll") for (int n = 0; n < 2; ++n) _Pragma("unroll") for (int k = 0; k < 2; ++k) \
        acc[ai][bj][m][n] = __builtin_amdgcn_mfma_f32_16x16x32_bf16(Bt[n][k], At[m][k], acc[ai][bj][m][n], 0, 0, 0); __builtin_amdgcn_s_setprio(0); } while (0)
#define PG8_WAIT_V(n) asm volatile("s_waitcnt vmcnt(" #n ")" ::: "memory")
#define PG8_WAIT_L(n) asm volatile("s_waitcnt lgkmcnt(" #n ")" ::: "memory")
#define PG8_BAR __builtin_amdgcn_s_barrier()
#define PG8_SCHED __builtin_amdgcn_sched_barrier(0)
    Unit cur, nxt; int ui = 0;
    if (!S.next(0, cur)) return;
    f32x4 acc[2][2][4][2];
#pragma unroll
    for (int a = 0; a < 2; ++a)
#pragma unroll
        for (int b = 0; b < 2; ++b)
#pragma unroll
            for (int m = 0; m < 4; ++m)
#pragma unroll
                for (int n = 0; n < 2; ++n) acc[a][b][m][n] = (f32x4){0.f, 0.f, 0.f, 0.f};
    bf16x8 At[4][2], B0[2][2], B1[2][2];
    const char* cA = (const char*)g.A + (size_t)cur.pm * tstep; const char* cB = (const char*)g.Bt + (size_t)cur.pn * tstep;
    S.a_ready(cur);
    if constexpr (SP2) {
        PG8_STAGE(PG8_SB(0, 0), cB, voffB); PG8_STAGE(PG8_SB(0, 1), cB + hstep, voffB); PG8_STAGE(PG8_SA(0, 0), cA, voffA); PG8_STAGE(PG8_SA(0, 1), cA + hstep, voffA);
        if (wr == 1) PG8_BAR;
        PG8_WAIT_V(2); PG8_BAR;
        PG8_STAGE(PG8_SB(1, 0), cB + kstep, voffB); PG8_STAGE(PG8_SA(1, 0), cA + kstep, voffA); PG8_STAGE(PG8_SB(1, 1), cB + hstep + kstep, voffB);
        PG8_WAIT_V(6); PG8_BAR;
    } else {
        PG8_STAGE(PG8_SB(0, 0), cB, voffB); PG8_STAGE(PG8_SA(0, 0), cA, voffA); PG8_STAGE(PG8_SB(0, 1), cB + hstep, voffB); PG8_STAGE(PG8_SA(0, 1), cA + hstep, voffA);
        if (wr == 1) PG8_BAR;
        PG8_WAIT_V(4); PG8_BAR;
        PG8_STAGE(PG8_SB(1, 0), cB + kstep, voffB); PG8_STAGE(PG8_SA(1, 0), cA + kstep, voffA); PG8_STAGE(PG8_SB(1, 1), cB + hstep + kstep, voffB);
        PG8_WAIT_V(6); PG8_BAR;
    }
    for (;;) {
        const bool has_next = S.next(ui + 1, nxt);
        const char* nA = has_next ? (const char*)g.A + (size_t)nxt.pm * tstep : cA; const char* nB = has_next ? (const char*)g.Bt + (size_t)nxt.pn * tstep : cB;
        for (int t = 0; t < nt; t += 2) {
            const bool last = (t == nt - 2);
            const char* a1 = cA + (size_t)(t + 1) * kstep;
            const char* a2 = last ? nA : cA + (size_t)(t + 2) * kstep; const char* b2 = last ? nB : cB + (size_t)(t + 2) * kstep;
            const char* a3 = a2 + kstep; const char* b3 = b2 + kstep;
            if (last && has_next) S.a_ready(nxt);
            if constexpr (SP2) {
            PG8_LDB(B0, 0, 0); PG8_LDB(B1, 0, 1); PG8_SCHED; PG8_LDA(At, 0, 0); PG8_STAGE(PG8_SA(1, 1), a1 + hstep, voffA);
            PG8_WAIT_V(8); PG8_WAIT_L(0); PG8_BAR; PG8_MMA(0, 0, At, B0); PG8_MMA(0, 1, At, B1); PG8_BAR; PG8_SCHED;
            PG8_LDA(At, 0, 1); PG8_STAGE(PG8_SB(0, 0), b2, voffB); PG8_STAGE(PG8_SB(0, 1), b2 + hstep, voffB); PG8_STAGE(PG8_SA(0, 0), a2, voffA);
            PG8_WAIT_V(8); PG8_WAIT_L(0); PG8_BAR; PG8_MMA(1, 0, At, B0); PG8_MMA(1, 1, At, B1); PG8_BAR; PG8_SCHED;
            PG8_LDB(B0, 1, 0); PG8_LDB(B1, 1, 1); PG8_SCHED; PG8_LDA(At, 1, 0); PG8_STAGE(PG8_SA(0, 1), a2 + hstep, voffA);
            PG8_WAIT_V(8); PG8_WAIT_L(0); PG8_BAR; PG8_MMA(0, 0, At, B0); PG8_MMA(0, 1, At, B1); PG8_BAR; PG8_SCHED;
            PG8_LDA(At, 1, 1); PG8_STAGE(PG8_SB(1, 0), b3, voffB); PG8_STAGE(PG8_SB(1, 1), b3 + hstep, voffB); PG8_STAGE(PG8_SA(1, 0), a3, voffA);
            PG8_WAIT_V(8); PG8_WAIT_L(0); PG8_BAR; PG8_MMA(1, 0, At, B0); PG8_MMA(1, 1, At, B1); PG8_BAR; PG8_SCHED;
            } else {
            PG8_LDB(B0, 0, 0); PG8_SCHED; PG8_LDA(At, 0, 0); PG8_STAGE(PG8_SA(1, 1), a1 + hstep, voffA);
            PG8_WAIT_L(8); PG8_BAR; PG8_WAIT_L(0); PG8_MMA(0, 0, At, B0); PG8_BAR; PG8_SCHED;
            PG8_LDB(B1, 0, 1); PG8_STAGE(PG8_SB(0, 0), b2, voffB);
            PG8_BAR; PG8_WAIT_L(0); PG8_MMA(0, 1, At, B1); PG8_BAR;
            PG8_LDA(At, 0, 1); PG8_STAGE(PG8_SA(0, 0), a2, voffA);
            PG8_BAR; PG8_WAIT_L(0); PG8_MMA(1, 0, At, B0); PG8_BAR; PG8_SCHED;
            PG8_STAGE(PG8_SB(0, 1), b2 + hstep, voffB);
            PG8_WAIT_V(6); PG8_BAR; PG8_MMA(1, 1, At, B1); PG8_BAR;
            PG8_LDB(B0, 1, 0); PG8_SCHED; PG8_LDA(At, 1, 0); PG8_STAGE(PG8_SA(0, 1), a2 + hstep, voffA);
            PG8_WAIT_L(8); PG8_BAR; PG8_WAIT_L(0); PG8_MMA(0, 0, At, B0); PG8_BAR; PG8_SCHED;
            PG8_LDB(B1, 1, 1); PG8_STAGE(PG8_SB(1, 0), b3, voffB);
            PG8_BAR; PG8_WAIT_L(0); PG8_MMA(0, 1, At, B1); PG8_BAR;
            PG8_LDA(At, 1, 1); PG8_STAGE(PG8_SA(1, 0), a3, voffA);
            PG8_BAR; PG8_WAIT_L(0); PG8_MMA(1, 0, At, B0); PG8_BAR; PG8_SCHED;
            PG8_STAGE(PG8_SB(1, 1), b3 + hstep, voffB);
            PG8_WAIT_V(6); PG8_BAR; PG8_MMA(1, 1, At, B1); PG8_BAR;
            }
        }
        if constexpr (ALIGN_EPI) { if (wr == 0) PG8_BAR; }
        if constexpr (!Epi::AFTER_DRAIN) { E(acc, cur, wr, wc, fr, fq); S.done(cur); }
        if (!has_next) break;
#pragma unroll
        for (int a = 0; a < 2; ++a)
#pragma unroll
            for (int b = 0; b < 2; ++b)
#pragma unroll
                for (int m = 0; m < 4; ++m)
#pragma unroll
                    for (int n = 0; n < 2; ++n) acc[a][b][m][n] = (f32x4){0.f, 0.f, 0.f, 0.f};
        cur = nxt; cA = nA; cB = nB; ++ui;
        if constexpr (ALIGN_EPI) { if (wr == 1) PG8_BAR; }
    }
    PG8_WAIT_V(0);
    if constexpr (!ALIGN_EPI) { if (wr == 0) PG8_BAR; }
    PG8_BAR;
    if constexpr (Epi::AFTER_DRAIN) { E.fused(acc, cur, wr, wc, fr, fq, lds, wid, lane); S.done(cur); }
#undef PG8_SA
#undef PG8_SB
#undef PG8_STAGE
#undef PG8_LDA
#undef PG8_LDB
#undef PG8_MMA
#undef PG8_WAIT_V
#undef PG8_WAIT_L
#undef PG8_BAR
#undef PG8_SCHED
}
}

#ifndef MK_PER_PHASE
#define MK_PER_PHASE 0
#endif
#define LAS __attribute__((address_space(3)))
typedef unsigned short bf16;
typedef short bf16x8 __attribute__((ext_vector_type(8)));
typedef float f32x4 __attribute__((ext_vector_type(4)));
typedef unsigned u32x2 __attribute__((ext_vector_type(2)));
typedef unsigned u32x4 __attribute__((ext_vector_type(4)));

constexpr int T = 8192, D = 2048, FF = 5632, SEQ = 4096;
constexpr int MEMT = 512;
constexpr int GLA_N = 5136, GLA_NP = 5376;
constexpr int CONV_N = 5120, CONV_LD = 3584;
constexpr int NITEM = 512;
constexpr float EPS = 1e-6f;
constexpr int NWAVES = 8, NTHR = 512;
constexpr int LDS_BYTES = 147456;

constexpr size_t SZ_FFI = (size_t)2 * FF * D * 2, SZ_FFO = (size_t)D * FF * 2, SZ_GLA = (size_t)GLA_NP * D * 2, SZ_CONV = (size_t)CONV_N * D * 2, SZ_MIX = (size_t)D * D * 2, SZ_KV = (size_t)1024 * D * 2;
constexpr size_t WS_FFI = 0;
constexpr size_t WS_FFO = WS_FFI + 4 * SZ_FFI;
constexpr size_t WS_GLA = WS_FFO + 4 * SZ_FFO;
constexpr size_t WS_CONV = WS_GLA + SZ_GLA;
constexpr size_t WS_MIX = WS_CONV + SZ_CONV;
constexpr size_t WS_KV = WS_MIX + 2 * SZ_MIX;
constexpr size_t WS_MEMN = WS_KV + 2 * SZ_KV;
constexpr size_t WS_KB = WS_MEMN + (size_t)2 * MEMT * D * 2;
constexpr size_t WS_VT = WS_KB + (size_t)2 * 512 * 512 * 2;
constexpr size_t WS_XN = WS_VT + (size_t)2 * 512 * 512 * 2;
constexpr size_t WS_HB = WS_XN + (size_t)T * D * 2;
constexpr size_t WS_Y = WS_HB + (size_t)T * FF * 2;
constexpr size_t WS_P = WS_Y + (size_t)T * D * 4;
constexpr size_t WS_CAT = WS_P + (size_t)T * GLA_NP * 2;
constexpr size_t WS_QT = WS_CAT + (size_t)T * D * 2;
constexpr size_t WS_AM = WS_QT + (size_t)T * 768 * 2;
constexpr size_t WS_UT = WS_AM + (size_t)NITEM * 4096 * 2;
constexpr size_t WS_ST = WS_UT + (size_t)NITEM * 73728 * 2;
constexpr size_t WS_DB = WS_ST + (size_t)NITEM * 73728 * 2;
constexpr size_t WS_END = WS_DB + (size_t)NITEM * 192 * 4;

struct Args {
    const float *x, *mem, *ffn_pre_g, *ffn_w_in, *ffn_w_out, *ffn_post_g, *mix_pre_g, *mix_post_g, *mem_g, *w_mem_kv, *w_mix_out, *gla_w_in, *gla_gate_w2, *gla_gate_b, *gla_head_g, *conv_w_in, *conv_w, *conv_b;
    float* out; unsigned char* ws; int ph_lo, ph_hi;
};

__device__ __forceinline__ float bf2f(bf16 v) { return __uint_as_float(((unsigned)v) << 16); }
__device__ __forceinline__ float bf_lo(unsigned w) { return __uint_as_float(w << 16); }
__device__ __forceinline__ float bf_hi(unsigned w) { return __uint_as_float(w & 0xffff0000u); }
__device__ __forceinline__ unsigned pk(float lo, float hi) { return pg8::cvt_pk_bf16(lo, hi); }
__device__ __forceinline__ bf16 f2bf1(float f) { return (bf16)(pg8::cvt_pk_bf16(f, 0.f) & 0xffffu); }
__device__ __forceinline__ f32x4 mfma16(bf16x8 a, bf16x8 b, f32x4 c) { return __builtin_amdgcn_mfma_f32_16x16x32_bf16(a, b, c, 0, 0, 0); }
__device__ __forceinline__ float wave_sum(float v) {
#pragma unroll
    for (int o = 1; o < 64; o <<= 1) v += __shfl_xor(v, o);
    return v;
}
__device__ __forceinline__ float silu_f(float g) { return g * __builtin_amdgcn_rcpf(1.f + __builtin_amdgcn_exp2f(-1.44269504f * g)); }
#define LDS_WAIT() asm volatile("s_waitcnt lgkmcnt(0)" ::: "memory")

namespace pg8 {
struct OffOrder : StaticOrder {
    __device__ bool next(int i, Unit& u) const { if (c < 0) return false; return StaticOrder::next(i, u); }
};
struct EpiF32 {
    static constexpr bool PERM = false, AFTER_DRAIN = false;
    float* C; int ldc;
    __device__ __forceinline__ void operator()(const f32x4 (&acc)[2][2][4][2], const Unit& u, int wr, int wc, int fr, int fq) const {
        const int row0 = u.pm * BM + wr * 64 + fr, col0 = u.pn * BM + wc * 32 + 4 * fq;
#pragma unroll
        for (int ai = 0; ai < 2; ++ai)
#pragma unroll
            for (int m = 0; m < 4; ++m) { float* rowp = C + (size_t)(row0 + ai * HALF + m * 16) * ldc + col0;
#pragma unroll
                for (int bj = 0; bj < 2; ++bj)
#pragma unroll
                    for (int n = 0; n < 2; ++n) *(f32x4*)(rowp + bj * HALF + n * 16) = acc[ai][bj][m][n]; }
    }
};
struct EpiPlain {
    static constexpr bool PERM = true, AFTER_DRAIN = false;
    bf16_t* O; int ldc;
    __device__ __forceinline__ void operator()(const f32x4 (&acc)[2][2][4][2], const Unit& u, int wr, int wc, int fr, int fq) const {
        const int row0 = u.pm * BM + wr * 64 + fr, col0 = u.pn * BM + wc * 32 + 8 * fq;
#pragma unroll
        for (int ai = 0; ai < 2; ++ai)
#pragma unroll
            for (int m = 0; m < 4; ++m) { bf16_t* rowp = O + (size_t)(row0 + ai * HALF + m * 16) * ldc + col0;
#pragma unroll
                for (int bj = 0; bj < 2; ++bj) { const f32x4 v0 = acc[ai][bj][m][0], v1 = acc[ai][bj][m][1];
                    u32x4 w; w.x = cvt_pk_bf16(v0[0], v0[1]); w.y = cvt_pk_bf16(v0[2], v0[3]); w.z = cvt_pk_bf16(v1[0], v1[1]); w.w = cvt_pk_bf16(v1[2], v1[3]);
                    *(u32x4*)(rowp + bj * HALF) = w; } }
    }
};
struct EpiGlu {
    static constexpr bool PERM = true, AFTER_DRAIN = false;
    bf16_t* O; int ldc;
    __device__ __forceinline__ void operator()(const f32x4 (&acc)[2][2][4][2], const Unit& u, int wr, int wc, int fr, int fq) const {
        const int row0 = u.pm * BM + wr * 64 + fr, col0 = u.pn * HALF + wc * 32 + 8 * fq;
#pragma unroll
        for (int ai = 0; ai < 2; ++ai)
#pragma unroll
            for (int m = 0; m < 4; ++m) { bf16_t* rowp = O + (size_t)(row0 + ai * HALF + m * 16) * ldc + col0;
                const f32x4 g0 = acc[ai][0][m][0], g1 = acc[ai][0][m][1], u0 = acc[ai][1][m][0], u1 = acc[ai][1][m][1];
                float h[8];
#pragma unroll
                for (int j = 0; j < 4; ++j) { h[j] = g0[j] * __builtin_amdgcn_rcpf(1.f + __builtin_amdgcn_exp2f(-1.44269504f * g0[j])) * u0[j];
                                              h[4 + j] = g1[j] * __builtin_amdgcn_rcpf(1.f + __builtin_amdgcn_exp2f(-1.44269504f * g1[j])) * u1[j]; }
                u32x4 w; w.x = cvt_pk_bf16(h[0], h[1]); w.y = cvt_pk_bf16(h[2], h[3]); w.z = cvt_pk_bf16(h[4], h[5]); w.w = cvt_pk_bf16(h[6], h[7]);
                *(u32x4*)rowp = w; }
    }
};
struct EpiConv {
    static constexpr bool PERM = true, AFTER_DRAIN = false;
    bf16_t* O; int ldc;
    __device__ __forceinline__ void operator()(const f32x4 (&acc)[2][2][4][2], const Unit& u, int wr, int wc, int fr, int fq) const {
        const int row0 = u.pm * BM + wr * 64 + fr;
        if (u.pn >= 6 && u.pn < 18) {
            const int col0 = 1536 + (u.pn - 6) * HALF + wc * 32 + 8 * fq;
#pragma unroll
            for (int ai = 0; ai < 2; ++ai)
#pragma unroll
                for (int m = 0; m < 4; ++m) { bf16_t* rowp = O + (size_t)(row0 + ai * HALF + m * 16) * ldc + col0;
                    const f32x4 v0 = acc[ai][0][m][0] * acc[ai][1][m][0], v1 = acc[ai][0][m][1] * acc[ai][1][m][1];
                    u32x4 w; w.x = cvt_pk_bf16(v0[0], v0[1]); w.y = cvt_pk_bf16(v0[2], v0[3]); w.z = cvt_pk_bf16(v1[0], v1[1]); w.w = cvt_pk_bf16(v1[2], v1[3]);
                    *(u32x4*)rowp = w; }
        } else {
            const int col0 = (u.pn < 6 ? u.pn * BM : 3072 + (u.pn - 18) * BM) + wc * 32 + 8 * fq;
#pragma unroll
            for (int ai = 0; ai < 2; ++ai)
#pragma unroll
                for (int m = 0; m < 4; ++m) { bf16_t* rowp = O + (size_t)(row0 + ai * HALF + m * 16) * ldc + col0;
#pragma unroll
                    for (int bj = 0; bj < 2; ++bj) { const f32x4 v0 = acc[ai][bj][m][0], v1 = acc[ai][bj][m][1];
                        u32x4 w; w.x = cvt_pk_bf16(v0[0], v0[1]); w.y = cvt_pk_bf16(v0[2], v0[3]); w.z = cvt_pk_bf16(v1[0], v1[1]); w.w = cvt_pk_bf16(v1[2], v1[3]);
                        *(u32x4*)(rowp + bj * HALF) = w; } }
        }
    }
};
}

__device__ __forceinline__ int rowmap(int kind, int n) {
    if (kind == 1) { if (n < FF) return 256 * (n >> 7) + (n & 127); n -= FF; return 256 * (n >> 7) + 128 + (n & 127); }
    if (kind == 2) { if (n < 4608) return n; if (n < 4624) return 5120 + (n - 4608); return n - 16; }
    if (kind == 3) { if (n < 1536 || n >= 4608) return n; if (n < 3072) { n -= 1536; return 1536 + 256 * (n >> 7) + (n & 127); }
                     n -= 3072; return 1536 + 256 * (n >> 7) + 128 + (n & 127); }
    return n;
}
__device__ __forceinline__ void transpose_item(const float* __restrict__ W, int K, int N, bf16* __restrict__ WT, int kind, LAS float* scr, int item, int lane) {
    const int nblk = (N + 31) >> 5, kb = item / nblk, nb = item - kb * nblk, k0 = 64 * kb, n0 = 32 * nb;
    const bool nok = (n0 + (lane & 31)) < N;
    const float* src = W + (size_t)(k0 + (lane >> 5)) * N + n0 + (lane & 31);
#pragma unroll 8
    for (int i = 0; i < 32; ++i) { const int kk = 2 * i + (lane >> 5); scr[kk * 33 + (lane & 31)] = nok ? src[(size_t)(2 * i) * N] : 0.f; }
    LDS_WAIT();
    const int c = lane & 7;
#pragma unroll
    for (int j = 0; j < 4; ++j) { const int n = (lane >> 3) + 8 * j; const LAS float* s = scr + (8 * c) * 33 + n;
        u32x4 o; o.x = pk(s[0 * 33], s[1 * 33]); o.y = pk(s[2 * 33], s[3 * 33]); o.z = pk(s[4 * 33], s[5 * 33]); o.w = pk(s[6 * 33], s[7 * 33]);
        if (n0 + n < N) *(u32x4*)(WT + (size_t)rowmap(kind, n0 + n) * K + k0 + 8 * c) = o; }
    LDS_WAIT();
}
__device__ __forceinline__ void norm_row_bf16(const float* __restrict__ xrow, const float* __restrict__ g, bf16* __restrict__ orow, int lane) {
    const f32x4* xr = (const f32x4*)xrow + lane; f32x4 v[8]; float s = 0.f;
#pragma unroll
    for (int j = 0; j < 8; ++j) { v[j] = xr[64 * j]; s += (v[j].x * v[j].x + v[j].y * v[j].y) + (v[j].z * v[j].z + v[j].w * v[j].w); }
    const float r = rsqrtf(wave_sum(s) * (1.f / D) + EPS);
    const f32x4* gr = (const f32x4*)g + lane; u32x2* o8 = (u32x2*)orow + lane;
#pragma unroll
    for (int j = 0; j < 8; ++j) { const f32x4 gg = gr[64 * j]; u32x2 o; o.x = pk(v[j].x * r * gg.x, v[j].y * r * gg.y); o.y = pk(v[j].z * r * gg.z, v[j].w * r * gg.w); o8[64 * j] = o; }
}
__device__ __forceinline__ int mat_items(int i) { return i < 4 ? 11264 : i < 8 ? 5632 : i == 8 ? 5152 : i == 9 ? 5120 : i < 12 ? 2048 : 1024; }
__device__ __forceinline__ void prologue(const Args& a, LAS unsigned char* lds, int wave, int lane) {
    LAS float* scr = (LAS float*)(lds + wave * 8704);
    const int gw = blockIdx.x * NWAVES + wave, NGW = gridDim.x * NWAVES;
    constexpr int NITEMS = 4 * 11264 + 4 * 5632 + 5152 + 5120 + 2 * 2048 + 2 * 1024;
    for (int it = gw; it < NITEMS; it += NGW) {
        int r = it, i = 0;
        for (; i < 13; ++i) { const int n = mat_items(i); if (r < n) break; r -= n; }
        const float* W; bf16* WT; int K = D, N, kind = 0;
        if (i < 4)       { W = a.ffn_w_in + (size_t)i * D * 2 * FF; WT = (bf16*)(a.ws + WS_FFI + i * SZ_FFI); N = 2 * FF; kind = 1; }
        else if (i < 8)  { W = a.ffn_w_out + (size_t)(i - 4) * FF * D; WT = (bf16*)(a.ws + WS_FFO + (i - 4) * SZ_FFO); K = FF; N = D; }
        else if (i == 8) { W = a.gla_w_in; WT = (bf16*)(a.ws + WS_GLA); N = GLA_N; kind = 2; }
        else if (i == 9) { W = a.conv_w_in; WT = (bf16*)(a.ws + WS_CONV); N = CONV_N; kind = 3; }
        else if (i < 12) { W = a.w_mix_out + (size_t)(i - 10) * D * D; WT = (bf16*)(a.ws + WS_MIX + (i - 10) * SZ_MIX); N = D; }
        else             { W = a.w_mem_kv + (size_t)(i - 12) * D * 1024; WT = (bf16*)(a.ws + WS_KV + (i - 12) * SZ_KV); N = 1024; }
        transpose_item(W, K, N, WT, kind, scr, r, lane);
    }
    { u32x4* z = (u32x4*)(a.ws + WS_GLA + (size_t)GLA_N * D * 2); const int n16 = (GLA_NP - GLA_N) * D * 2 / 16;
      for (int i = gw * 64 + lane; i < n16; i += NGW * 64) z[i] = (u32x4){0u, 0u, 0u, 0u}; }
    for (int m = gw; m < 2 * MEMT; m += NGW) { const int l = m / MEMT, r = m - l * MEMT; norm_row_bf16(a.mem + (size_t)r * D, a.mem_g + l * D, (bf16*)(a.ws + WS_MEMN) + (size_t)m * D, lane); }
    for (int m = gw; m < T; m += NGW) norm_row_bf16(a.x + (size_t)m * D, a.ffn_pre_g, (bf16*)(a.ws + WS_XN) + (size_t)m * D, lane);
}

__device__ __forceinline__ void e_pass(const float* __restrict__ xin, const float* __restrict__ y, float alpha, const float* __restrict__ gpost, float* __restrict__ xout, const float* __restrict__ gnext, bf16* __restrict__ xn, int wave, int lane) {
    const int gw = blockIdx.x * NWAVES + wave, NGW = gridDim.x * NWAVES;
    for (int m = gw; m < T; m += NGW) {
        const f32x4* yr = (const f32x4*)(y + (size_t)m * D) + lane; const f32x4* xr = (const f32x4*)(xin + (size_t)m * D) + lane;
        f32x4 v[8], xv[8]; float s = 0.f;
#pragma unroll
        for (int j = 0; j < 8; ++j) { v[j] = yr[64 * j]; xv[j] = xr[64 * j]; s += (v[j].x * v[j].x + v[j].y * v[j].y) + (v[j].z * v[j].z + v[j].w * v[j].w); }
        const float ry = rsqrtf(wave_sum(s) * (1.f / D) + EPS) * alpha;
        const f32x4* gp = (const f32x4*)gpost + lane; f32x4* xo = (f32x4*)(xout + (size_t)m * D) + lane; float s2 = 0.f;
#pragma unroll
        for (int j = 0; j < 8; ++j) { const f32x4 gg = gp[64 * j]; xv[j] = xv[j] + v[j] * gg * ry; xo[64 * j] = xv[j]; s2 += (xv[j].x * xv[j].x + xv[j].y * xv[j].y) + (xv[j].z * xv[j].z + xv[j].w * xv[j].w); }
        if (gnext) {
            const float rx = rsqrtf(wave_sum(s2) * (1.f / D) + EPS);
            const f32x4* gn = (const f32x4*)gnext + lane; u32x2* o8 = (u32x2*)(xn + (size_t)m * D) + lane;
#pragma unroll
            for (int j = 0; j < 8; ++j) { const f32x4 gg = gn[64 * j]; u32x2 o; o.x = pk(xv[j].x * rx * gg.x, xv[j].y * rx * gg.y); o.y = pk(xv[j].z * rx * gg.z, xv[j].w * rx * gg.w); o8[64 * j] = o; }
        }
    }
}

constexpr int SP_LD = 264;
__device__ __forceinline__ void memattn_item(int item, const bf16* __restrict__ xq, int ldq, int qcol0, const bf16* __restrict__ Kb, const bf16* __restrict__ Vt, bf16* __restrict__ CAT, LAS unsigned char* lds, int w, int lane) {
    LAS bf16* sP = (LAS bf16*)lds;
    LAS float* sMax = (LAS float*)(lds + 64 * SP_LD * 2);
    LAS float* sSum = sMax + 128;
    const int tile = item >> 2, head = item & 3, t0 = tile * 64, b = t0 / SEQ;
    const int l15 = lane & 15, q = lane >> 4, rt = w & 3, half = w >> 2;
    f32x4 s[8];
#pragma unroll
    for (int ct = 0; ct < 8; ++ct) s[ct] = (f32x4){0.f, 0.f, 0.f, 0.f};
    const bf16* qrow = xq + (size_t)(t0 + 16 * rt + l15) * ldq + qcol0 + head * 128 + 8 * q;
    const bf16* krow = Kb + (size_t)(b * 256 + 128 * half + l15) * 512 + head * 128 + 8 * q;
#pragma unroll
    for (int ks = 0; ks < 4; ++ks) {
        const bf16x8 af = *(const bf16x8*)(qrow + 32 * ks);
#pragma unroll
        for (int ct = 0; ct < 8; ++ct) { const bf16x8 bfr = *(const bf16x8*)(krow + (size_t)(16 * ct) * 512 + 32 * ks); s[ct] = mfma16(bfr, af, s[ct]); }
    }
    const float sc = 0.08838834764831845f * 1.44269504f;
    float mx = -3.0e38f;
#pragma unroll
    for (int ct = 0; ct < 8; ++ct) { s[ct] = s[ct] * sc; mx = fmaxf(mx, fmaxf(fmaxf(s[ct][0], s[ct][1]), fmaxf(s[ct][2], s[ct][3]))); }
    mx = fmaxf(mx, __shfl_xor(mx, 16)); mx = fmaxf(mx, __shfl_xor(mx, 32));
    if (q == 0) sMax[half * 64 + 16 * rt + l15] = mx;
    __syncthreads();
    const float m = fmaxf(sMax[16 * rt + l15], sMax[64 + 16 * rt + l15]);
    float sum = 0.f;
#pragma unroll
    for (int ct = 0; ct < 8; ++ct) {
        f32x4 p; p[0] = __builtin_amdgcn_exp2f(s[ct][0] - m); p[1] = __builtin_amdgcn_exp2f(s[ct][1] - m); p[2] = __builtin_amdgcn_exp2f(s[ct][2] - m); p[3] = __builtin_amdgcn_exp2f(s[ct][3] - m);
        sum += (p[0] + p[1]) + (p[2] + p[3]);
        u32x2 o; o.x = pk(p[0], p[1]); o.y = pk(p[2], p[3]);
        *(LAS u32x2*)(sP + (16 * rt + l15) * SP_LD + 128 * half + 16 * ct + 4 * q) = o;
    }
    sum += __shfl_xor(sum, 16); sum += __shfl_xor(sum, 32);
    if (q == 0) sSum[half * 64 + 16 * rt + l15] = sum;
    __syncthreads();
    const float rs = 1.f / (sSum[16 * rt + l15] + sSum[64 + 16 * rt + l15]);
    const int dh = half;
    f32x4 o[4];
#pragma unroll
    for (int ct = 0; ct < 4; ++ct) o[ct] = (f32x4){0.f, 0.f, 0.f, 0.f};
    const bf16* vrow = Vt + (size_t)(head * 128 + 64 * dh + l15) * 512 + b * 256 + 8 * q;
#pragma unroll
    for (int ks = 0; ks < 8; ++ks) {
        const bf16x8 af = *(const LAS bf16x8*)(sP + (16 * rt + l15) * SP_LD + 32 * ks + 8 * q);
#pragma unroll
        for (int ct = 0; ct < 4; ++ct) { const bf16x8 bfr = *(const bf16x8*)(vrow + (size_t)(16 * ct) * 512 + 32 * ks); o[ct] = mfma16(bfr, af, o[ct]); }
    }
    bf16* orow = CAT + (size_t)(t0 + 16 * rt + l15) * D + 1536 + head * 128 + 64 * dh + 4 * q;
#pragma unroll
    for (int ct = 0; ct < 4; ++ct) { u32x2 ov; ov.x = pk(o[ct][0] * rs, o[ct][1] * rs); ov.y = pk(o[ct][2] * rs, o[ct][3] * rs); *(u32x2*)(orow + 16 * ct) = ov; }
}

constexpr int SQ_LD = 200, ST_LD = 72;
constexpr int L_SQ = 0, L_SKIN = 25600, L_SKOT = 51200, L_SVT = 78848, L_SG = 134144, L_STOT = 138240;
__device__ __forceinline__ void load_vT(LAS bf16* sVT, const bf16* __restrict__ P, int t0, int h, int tid) {
#pragma unroll 4
    for (int i = 0; i < 24; ++i) { const int idx = tid + 512 * i, vcol = idx % 384, tp = idx / 384;
        const bf16* src = P + (size_t)(t0 + 2 * tp) * GLA_NP + 1536 + h * 384 + vcol;
        const unsigned lo = src[0], hi = src[GLA_NP];
        *(LAS unsigned*)(sVT + vcol * ST_LD + 2 * tp) = lo | (hi << 16); }
}
__device__ __forceinline__ void gla_a_item(int item, const Args& a, LAS unsigned char* lds, int tid, int w, int lane) {
    const bf16* __restrict__ P = (const bf16*)(a.ws + WS_P);
    bf16* __restrict__ QT = (bf16*)(a.ws + WS_QT); bf16* __restrict__ AM = (bf16*)(a.ws + WS_AM); bf16* __restrict__ UT = (bf16*)(a.ws + WS_UT); float* __restrict__ DB = (float*)(a.ws + WS_DB);
    LAS bf16* sQ = (LAS bf16*)(lds + L_SQ); LAS bf16* sKin = (LAS bf16*)(lds + L_SKIN); LAS bf16* sKoT = (LAS bf16*)(lds + L_SKOT); LAS bf16* sVT = (LAS bf16*)(lds + L_SVT);
    LAS float* sG = (LAS float*)(lds + L_SG); LAS float* sTot = (LAS float*)(lds + L_STOT);
    const int bh = item >> 6, c = item & 63, b = bh >> 2, h = bh & 3, t0 = b * SEQ + 64 * c;
    const int l15 = lane & 15, q = lane >> 4;
#pragma unroll
    for (int i = 0; i < 2; ++i) { const int idx = tid + 512 * i, t = idx >> 4, r = idx & 15; sG[idx] = bf2f(P[(size_t)(t0 + t) * GLA_NP + 5120 + r]); }
    load_vT(sVT, P, t0, h, tid);
    __syncthreads();
    const int kk = tid % 192, half = tid / 192, tb = 32 * half;
    float la[32];
    if (tid < 384) {
        float w2c[16];
#pragma unroll
        for (int r = 0; r < 16; ++r) w2c[r] = a.gla_gate_w2[r * 768 + h * 192 + kk];
        const float bias = a.gla_gate_b[h * 192 + kk];
        float run = 0.f;
#pragma unroll
        for (int i = 0; i < 32; ++i) {
            const LAS f32x4* g4 = (const LAS f32x4*)(sG + (tb + i) * 16);
            float z = bias;
#pragma unroll
            for (int r4 = 0; r4 < 4; ++r4) { const f32x4 gv = g4[r4]; z += (gv.x * w2c[4 * r4] + gv.y * w2c[4 * r4 + 1]) + (gv.z * w2c[4 * r4 + 2] + gv.w * w2c[4 * r4 + 3]); }
            const float ls = fminf(z, 0.f) - __logf(1.f + __expf(-fabsf(z)));
            run += ls * 0.0625f; la[i] = run;
        }
        sTot[half * 192 + kk] = run;
    }
    __syncthreads();
    if (tid < 384) {
        const float tot0 = sTot[kk], tot1 = sTot[192 + kk], last = tot0 + tot1, base = half ? tot0 : 0.f;
        const float qscale = 0.07216878364870323f;
#pragma unroll
        for (int i = 0; i < 32; i += 2) {
            float ko[2];
#pragma unroll
            for (int e = 0; e < 2; ++e) {
                const int t = tb + i + e; const float cum = la[i + e] + base;
                const bf16* prow = P + (size_t)(t0 + t) * GLA_NP + h * 192 + kk;
                const float qv = bf2f(prow[0]) * qscale, kv = bf2f(prow[768]);
                const bf16 qt = f2bf1(qv * __expf(cum));
                sQ[t * SQ_LD + kk] = qt; QT[(size_t)(t0 + t) * 768 + h * 192 + kk] = qt;
                sKin[t * SQ_LD + kk] = f2bf1(kv * __expf(-cum));
                ko[e] = kv * __expf(last - cum);
            }
            *(LAS unsigned*)(sKoT + kk * ST_LD + tb + i) = pk(ko[0], ko[1]);
        }
        if (half == 0) DB[item * 192 + kk] = __expf(last);
    }
    __syncthreads();
    { const int rt = w >> 1;
#pragma unroll
      for (int cc = 0; cc < 2; ++cc) { const int ct = 2 * (w & 1) + cc; f32x4 acc = (f32x4){0.f, 0.f, 0.f, 0.f};
          if (ct <= rt) {
#pragma unroll
              for (int ks = 0; ks < 6; ++ks) { const bf16x8 af = *(const LAS bf16x8*)(sQ + (16 * rt + l15) * SQ_LD + 32 * ks + 8 * q), bfr = *(const LAS bf16x8*)(sKin + (16 * ct + l15) * SQ_LD + 32 * ks + 8 * q); acc = mfma16(bfr, af, acc); }
          }
          const int t = 16 * rt + l15, s0 = 16 * ct + 4 * q;
#pragma unroll
          for (int j = 0; j < 4; ++j) acc[j] = (s0 + j <= t) ? acc[j] : 0.f;
          u32x2 o; o.x = pk(acc[0], acc[1]); o.y = pk(acc[2], acc[3]);
          *(u32x2*)(AM + (size_t)item * 4096 + t * 64 + s0) = o; } }
    { bf16x8 af[3][2];
#pragma unroll
      for (int rt = 0; rt < 3; ++rt)
#pragma unroll
          for (int ks = 0; ks < 2; ++ks) af[rt][ks] = *(const LAS bf16x8*)(sVT + (48 * w + 16 * rt + l15) * ST_LD + 32 * ks + 8 * q);
      bf16* ubase = UT + (size_t)item * 73728 + (size_t)(48 * w + l15) * 192 + 4 * q;
#pragma unroll 4
      for (int ct = 0; ct < 12; ++ct) {
          const bf16x8 b0 = *(const LAS bf16x8*)(sKoT + (16 * ct + l15) * ST_LD + 8 * q), b1 = *(const LAS bf16x8*)(sKoT + (16 * ct + l15) * ST_LD + 32 + 8 * q);
#pragma unroll
          for (int rt = 0; rt < 3; ++rt) { f32x4 acc = (f32x4){0.f, 0.f, 0.f, 0.f}; acc = mfma16(b0, af[rt][0], acc); acc = mfma16(b1, af[rt][1], acc);
              u32x2 o; o.x = pk(acc[0], acc[1]); o.y = pk(acc[2], acc[3]);
              *(u32x2*)(ubase + (size_t)(16 * rt) * 192 + 16 * ct) = o; }
      } }
    __syncthreads();
}
__device__ __forceinline__ void gla_b(const Args& a, int tid) {
    const bf16* __restrict__ UT = (const bf16*)(a.ws + WS_UT); bf16* __restrict__ STt = (bf16*)(a.ws + WS_ST); const float* __restrict__ DB = (const float*)(a.ws + WS_DB);
    for (int wi = blockIdx.x * NTHR + tid; wi < 8 * 9216; wi += gridDim.x * NTHR) {
        const int bh = wi / 9216, e = (wi - bh * 9216) * 8, k0 = e % 192;
        float S[8];
#pragma unroll
        for (int j = 0; j < 8; ++j) S[j] = 0.f;
#pragma unroll 4
        for (int c = 0; c < 64; ++c) {
            const int item = bh * 64 + c; const size_t off = (size_t)item * 73728 + e;
            const u32x4 u = *(const u32x4*)(UT + off);
            const f32x4 d0 = *(const f32x4*)(DB + item * 192 + k0), d1 = *(const f32x4*)(DB + item * 192 + k0 + 4);
            u32x4 so; so.x = pk(S[0], S[1]); so.y = pk(S[2], S[3]); so.z = pk(S[4], S[5]); so.w = pk(S[6], S[7]);
            *(u32x4*)(STt + off) = so;
            S[0] = d0.x * S[0] + bf_lo(u.x); S[1] = d0.y * S[1] + bf_hi(u.x); S[2] = d0.z * S[2] + bf_lo(u.y); S[3] = d0.w * S[3] + bf_hi(u.y);
            S[4] = d1.x * S[4] + bf_lo(u.z); S[5] = d1.y * S[5] + bf_hi(u.z); S[6] = d1.z * S[6] + bf_lo(u.w); S[7] = d1.w * S[7] + bf_hi(u.w);
        }
    }
}
__device__ __forceinline__ void gla_c_item(int item, const Args& a, LAS unsigned char* lds, int tid, int w, int lane) {
    const bf16* __restrict__ P = (const bf16*)(a.ws + WS_P); const bf16* __restrict__ QT = (const bf16*)(a.ws + WS_QT); const bf16* __restrict__ AM = (const bf16*)(a.ws + WS_AM);
    const bf16* __restrict__ STt = (const bf16*)(a.ws + WS_ST); bf16* __restrict__ CAT = (bf16*)(a.ws + WS_CAT);
    LAS bf16* sVT = (LAS bf16*)(lds + L_SVT); LAS float* sSS = (LAS float*)(lds + L_SG);
    const int bh = item >> 6, c = item & 63, b = bh >> 2, h = bh & 3, t0 = b * SEQ + 64 * c;
    const int l15 = lane & 15, q = lane >> 4;
    load_vT(sVT, P, t0, h, tid);
    __syncthreads();
    f32x4 acc[4][3];
#pragma unroll
    for (int rt = 0; rt < 4; ++rt)
#pragma unroll
        for (int ct = 0; ct < 3; ++ct) acc[rt][ct] = (f32x4){0.f, 0.f, 0.f, 0.f};
#pragma unroll
    for (int ks = 0; ks < 2; ++ks) {
        bf16x8 af[4], bfr[3];
#pragma unroll
        for (int rt = 0; rt < 4; ++rt) af[rt] = *(const bf16x8*)(AM + (size_t)item * 4096 + (16 * rt + l15) * 64 + 32 * ks + 8 * q);
#pragma unroll
        for (int ct = 0; ct < 3; ++ct) bfr[ct] = *(const LAS bf16x8*)(sVT + (48 * w + 16 * ct + l15) * ST_LD + 32 * ks + 8 * q);
#pragma unroll
        for (int rt = 0; rt < 4; ++rt)
#pragma unroll
            for (int ct = 0; ct < 3; ++ct) acc[rt][ct] = mfma16(bfr[ct], af[rt], acc[rt][ct]);
    }
#pragma unroll 2
    for (int ks = 0; ks < 6; ++ks) {
        bf16x8 af[4], bfr[3];
#pragma unroll
        for (int rt = 0; rt < 4; ++rt) af[rt] = *(const bf16x8*)(QT + (size_t)(t0 + 16 * rt + l15) * 768 + h * 192 + 32 * ks + 8 * q);
#pragma unroll
        for (int ct = 0; ct < 3; ++ct) bfr[ct] = *(const bf16x8*)(STt + (size_t)item * 73728 + (size_t)(48 * w + 16 * ct + l15) * 192 + 32 * ks + 8 * q);
#pragma unroll
        for (int rt = 0; rt < 4; ++rt)
#pragma unroll
            for (int ct = 0; ct < 3; ++ct) acc[rt][ct] = mfma16(bfr[ct], af[rt], acc[rt][ct]);
    }
#pragma unroll
    for (int rt = 0; rt < 4; ++rt) { float ss = 0.f;
#pragma unroll
        for (int ct = 0; ct < 3; ++ct) ss += (acc[rt][ct][0] * acc[rt][ct][0] + acc[rt][ct][1] * acc[rt][ct][1]) + (acc[rt][ct][2] * acc[rt][ct][2] + acc[rt][ct][3] * acc[rt][ct][3]);
        ss += __shfl_xor(ss, 16); ss += __shfl_xor(ss, 32);
        if (q == 0) sSS[w * 64 + 16 * rt + l15] = ss; }
    __syncthreads();
#pragma unroll
    for (int rt = 0; rt < 4; ++rt) { float tot = 0.f;
#pragma unroll
        for (int ww = 0; ww < 8; ++ww) tot += sSS[ww * 64 + 16 * rt + l15];
        const float rinv = rsqrtf(tot * (1.f / 384.f) + EPS);
        const int t = t0 + 16 * rt + l15;
#pragma unroll
        for (int ct = 0; ct < 3; ++ct) { const int vcol = 48 * w + 16 * ct + 4 * q;
            const f32x4 hg = *(const f32x4*)(a.gla_head_g + vcol);
            const u32x2 rr = *(const u32x2*)(P + (size_t)t * GLA_NP + 3072 + h * 384 + vcol);
            const float r0 = bf_lo(rr.x), r1 = bf_hi(rr.x), r2 = bf_lo(rr.y), r3 = bf_hi(rr.y);
            u32x2 o; o.x = pk(acc[rt][ct][0] * rinv * hg.x * silu_f(r0), acc[rt][ct][1] * rinv * hg.y * silu_f(r1)); o.y = pk(acc[rt][ct][2] * rinv * hg.z * silu_f(r2), acc[rt][ct][3] * rinv * hg.w * silu_f(r3));
            *(u32x2*)(CAT + (size_t)t * D + h * 384 + vcol) = o; } }
    __syncthreads();
}

__device__ __forceinline__ void conv_pass(const Args& a, int tid) {
    const bf16* __restrict__ Pc = (const bf16*)(a.ws + WS_P); bf16* __restrict__ CAT = (bf16*)(a.ws + WS_CAT);
    for (int wi = blockIdx.x * NTHR + tid; wi < T * 192; wi += gridDim.x * NTHR) {
        const int t = wi / 192, c0 = (wi - t * 192) * 8, tl = t & (SEQ - 1);
        const bf16* row = Pc + (size_t)t * CONV_LD;
        const u32x4 bg = *(const u32x4*)(row + c0), u2 = *(const u32x4*)(row + 1536 + c0);
        u32x4 u1 = (u32x4){0u, 0u, 0u, 0u}, u0 = (u32x4){0u, 0u, 0u, 0u};
        if (tl >= 1) u1 = *(const u32x4*)(row - CONV_LD + 1536 + c0);
        if (tl >= 2) u0 = *(const u32x4*)(row - 2 * CONV_LD + 1536 + c0);
        const unsigned bgw[4] = {bg.x, bg.y, bg.z, bg.w}, u2w[4] = {u2.x, u2.y, u2.z, u2.w}, u1w[4] = {u1.x, u1.y, u1.z, u1.w}, u0w[4] = {u0.x, u0.y, u0.z, u0.w};
        unsigned ow[4];
#pragma unroll
        for (int j = 0; j < 4; ++j) { const int cc = c0 + 2 * j;
            const float ya = a.conv_w[cc] * bf_lo(u0w[j]) + a.conv_w[1536 + cc] * bf_lo(u1w[j]) + a.conv_w[3072 + cc] * bf_lo(u2w[j]) + a.conv_b[cc];
            const float yb = a.conv_w[cc + 1] * bf_hi(u0w[j]) + a.conv_w[1536 + cc + 1] * bf_hi(u1w[j]) + a.conv_w[3072 + cc + 1] * bf_hi(u2w[j]) + a.conv_b[cc + 1];
            ow[j] = pk(bf_lo(bgw[j]) * ya, bf_hi(bgw[j]) * yb); }
        *(u32x4*)(CAT + (size_t)t * D + c0) = (u32x4){ow[0], ow[1], ow[2], ow[3]};
    }
}

constexpr int PH_PER_LAYER = 12, N_PHASES = 1 + 2 * PH_PER_LAYER;
__global__ void __launch_bounds__(NTHR, 2) mk_fwd(Args a) {
    extern __shared__ __attribute__((aligned(16))) unsigned char lds_raw[];
    LAS unsigned char* lds = (LAS unsigned char*)lds_raw;
    cg::grid_group grid = cg::this_grid();
    const int G = gridDim.x;
    bool first = true;
    for (int ph = a.ph_lo; ph < a.ph_hi; ++ph) {
        int tid_ = threadIdx.x; asm volatile("" : "+v"(tid_));
        const int tid = tid_, lane = tid & 63, wave = __builtin_amdgcn_readfirstlane(tid >> 6);
        unsigned char* ws = a.ws; asm volatile("" : "+s"(ws));
        const int l = (ph - 1) / PH_PER_LAYER, sub = (ph - 1) - l * PH_PER_LAYER;
        if (ph > 0 && l == 1 && (sub == 5 || sub == 6)) continue;
        if (!first) grid.sync();
        first = false;
        if (ph == 0) {
#ifndef DIS_PRO
 prologue(a, lds, wave, lane);
#endif
 continue; }
        if (sub == 0 || sub == 9) {
            const int fi = 2 * l + (sub == 9);
            pg8::Gemm g{(const pg8::bf16_t*)(ws + WS_XN), (const pg8::bf16_t*)(ws + WS_FFI + fi * SZ_FFI), T, 2 * FF, D};
            pg8::StaticOrder S; S.init(T, 2 * FF, G, (int)blockIdx.x);
            pg8::EpiGlu E{(pg8::bf16_t*)(ws + WS_HB), FF};
#ifndef DIS_G1
            pg8::gemm_phase<pg8::EpiGlu, pg8::StaticOrder, true, true>(lds, g, S, E);
#endif
            if (ph == 1) {
#pragma unroll 1
                for (int j = 0; j < 4; ++j) { const int ll = j >> 1, isv = j & 1;
                    const pg8::bf16_t* memn = (const pg8::bf16_t*)(ws + WS_MEMN) + (size_t)ll * MEMT * D; const pg8::bf16_t* wkv = (const pg8::bf16_t*)(ws + WS_KV + ll * SZ_KV);
                    pg8::Gemm g2{isv ? wkv + (size_t)512 * D : memn, isv ? memn : wkv, 512, 512, D};
                    pg8::OffOrder S2; S2.init(512, 512, G, (int)blockIdx.x - 128 - 4 * j); if (S2.c >= 4) S2.c = -1;
                    pg8::EpiPlain E2{(pg8::bf16_t*)(ws + (isv ? WS_VT : WS_KB)) + (size_t)ll * 512 * 512, 512};

#ifndef DIS_GKV
                    pg8::gemm_phase<pg8::EpiPlain, pg8::OffOrder, true, true>(lds, g2, S2, E2);
#endif
 }
            }
        } else if (sub == 1 || sub == 10 || sub == 7) {
            const int fi = 2 * l + (sub == 10);
            pg8::Gemm g{(const pg8::bf16_t*)(ws + (sub == 7 ? WS_CAT : WS_HB)), (const pg8::bf16_t*)(ws + (sub == 7 ? WS_MIX + l * SZ_MIX : WS_FFO + fi * SZ_FFO)), T, D, sub == 7 ? D : FF};
            pg8::StaticOrder S; S.init(T, D, G, (int)blockIdx.x);
            pg8::EpiF32 E{(float*)(ws + WS_Y), D};
#ifndef DIS_G2
            pg8::gemm_phase<pg8::EpiF32, pg8::StaticOrder, true, true>(lds, g, S, E);
#endif
        } else if (sub == 2 || sub == 8 || sub == 11) {
            const float* xin = (ph == 3) ? a.x : a.out;
            const float alpha = (sub == 8) ? 1.f : 0.5f;
            const float* gpost = (sub == 8) ? a.mix_post_g + l * D : a.ffn_post_g + (2 * l + (sub == 11)) * D;
            const float* gnext = (sub == 2) ? a.mix_pre_g + l * D : (sub == 8) ? a.ffn_pre_g + (2 * l + 1) * D : (l == 0 ? a.ffn_pre_g + 2 * D : nullptr);
#ifndef DIS_E
            e_pass(xin, (const float*)(ws + WS_Y), alpha, gpost, a.out, gnext, (bf16*)(ws + WS_XN), wave, lane);
#endif
        } else if (sub == 3) {
            if (l == 0) {
                pg8::Gemm g{(const pg8::bf16_t*)(ws + WS_XN), (const pg8::bf16_t*)(ws + WS_GLA), T, GLA_NP, D};
                pg8::StaticOrder S; S.init(T, GLA_NP, G, (int)blockIdx.x);
                pg8::EpiPlain E{(pg8::bf16_t*)(ws + WS_P), GLA_NP};
#ifndef DIS_GGLA
                pg8::gemm_phase<pg8::EpiPlain, pg8::StaticOrder, true, true>(lds, g, S, E);
#endif
            } else {
                pg8::Gemm g{(const pg8::bf16_t*)(ws + WS_XN), (const pg8::bf16_t*)(ws + WS_CONV), T, CONV_N, D};
                pg8::StaticOrder S; S.init(T, CONV_N, G, (int)blockIdx.x);
                pg8::EpiConv E{(pg8::bf16_t*)(ws + WS_P), CONV_LD};
#ifndef DIS_GCONV
                pg8::gemm_phase<pg8::EpiConv, pg8::StaticOrder, true, true>(lds, g, S, E);
#endif
            }
        } else if (sub == 4) {
            if (l == 0) {
#ifndef DIS_GLAA
 for (int it = blockIdx.x; it < NITEM; it += G) gla_a_item(it, a, lds, tid, wave, lane);
#endif
 }
            else {
#ifndef DIS_CONV
 conv_pass(a, tid);
#endif
 }
            const bf16* Kb = (const bf16*)(ws + WS_KB) + (size_t)l * 512 * 512; const bf16* Vt = (const bf16*)(ws + WS_VT) + (size_t)l * 512 * 512;

#ifndef DIS_MATT
 for (int it = blockIdx.x; it < 512; it += G) { memattn_item(it, (const bf16*)(ws + WS_P), l == 0 ? GLA_NP : CONV_LD, l == 0 ? 4608 : 3072, Kb, Vt, (bf16*)(ws + WS_CAT), lds, wave, lane); __syncthreads(); }
#endif
        } else if (sub == 5) {
#ifndef DIS_GLAB
 gla_b(a, tid);
#endif

        } else if (sub == 6) {
#ifndef DIS_GLAC
 for (int it = blockIdx.x; it < NITEM; it += G) gla_c_item(it, a, lds, tid, wave, lane);
#endif
 }
    }
#ifdef DIAG_BUF
    {   grid.sync();
        const bf16* src = (const bf16*)(a.ws + DIAG_BUF); const size_t n = (size_t)DIAG_N, tot = (size_t)T * D;
        for (size_t i = (size_t)blockIdx.x * NTHR + threadIdx.x; i < tot; i += (size_t)gridDim.x * NTHR) { float s = 0.f; for (size_t j = i; j < n; j += tot) s += bf2f(src[j]); a.out[i] = (fabsf(s) < 1e30f) ? s : 77777.f; }
    }
#endif
}

extern "C" void kernel_launch(void* const* d_in, const int* in_sizes, int n_in, void* d_out, int out_size, void* d_ws, size_t ws_size, hipStream_t stream) {
    static int grid = 0;
    if (grid == 0) {
        if (n_in != 18 || in_sizes[0] != T * D || out_size != T * D || ws_size < WS_END) { fprintf(stderr, "kernel_launch: unexpected shapes / workspace (n_in %d, in0 %d, out %d, ws %zu, need %zu)\n", n_in, n_in > 0 ? in_sizes[0] : -1, out_size, ws_size, (size_t)WS_END); grid = -1; return; }
        int dev = 0, cus = 0, per_cu = 0;
        if (hipGetDevice(&dev) != hipSuccess || hipDeviceGetAttribute(&cus, hipDeviceAttributeMultiprocessorCount, dev) != hipSuccess) { grid = -1; return; }
        if (hipFuncSetAttribute((const void*)mk_fwd, hipFuncAttributeMaxDynamicSharedMemorySize, LDS_BYTES) != hipSuccess) { fprintf(stderr, "kernel_launch: hipFuncSetAttribute failed\n"); grid = -1; return; }
        if (hipOccupancyMaxActiveBlocksPerMultiprocessor(&per_cu, (const void*)mk_fwd, NTHR, LDS_BYTES) != hipSuccess || per_cu < 1) { fprintf(stderr, "kernel_launch: occupancy query says %d\n", per_cu); per_cu = 1; }
        (void)hipGetLastError();
        grid = cus * 1;
        fprintf(stderr, "kernel_launch: grid %d (cus %d, per_cu %d)\n", grid, cus, per_cu);
    }
    if (grid < 0) return;
    Args a{};
    const float** ap = (const float**)&a;
    for (int i = 0; i < 18; ++i) ap[i] = (const float*)d_in[i];
    a.out = (float*)d_out; a.ws = (unsigned char*)d_ws;
#if MK_PER_PHASE
    for (int ph = 0; ph < N_PHASES; ++ph) {
        if (ph > 12 && ((ph - 1) % PH_PER_LAYER == 5 || (ph - 1) % PH_PER_LAYER == 6)) continue;
        a.ph_lo = ph; a.ph_hi = ph + 1;
        hipLaunchKernelGGL(mk_fwd, dim3(grid), dim3(NTHR), LDS_BYTES, stream, a);
    }
#else
#ifdef DIAG_HI
    a.ph_lo = 0; a.ph_hi = DIAG_HI;
#else
    a.ph_lo = 0; a.ph_hi = N_PHASES;
#endif
    void* args[] = {&a};
    hipError_t e = hipLaunchCooperativeKernel((const void*)mk_fwd, dim3(grid), dim3(NTHR), args, LDS_BYTES, stream);
    if (e != hipSuccess) fprintf(stderr, "kernel_launch: cooperative launch failed: %s (grid %d)\n", hipGetErrorString(e), grid);
#endif
}
```

```cpp
#include <hip/hip_runtime.h>
#include <hip/hip_cooperative_groups.h>
#include <cstdio>
#include <cstdint>
namespace cg = cooperative_groups;
namespace pg8 {
#define PG8_LAS __attribute__((address_space(3)))
typedef unsigned short bf16_t;
typedef short bf16x8 __attribute__((ext_vector_type(8)));
typedef float f32x4 __attribute__((ext_vector_type(4)));
typedef unsigned u32x4 __attribute__((ext_vector_type(4)));
constexpr int BM = 256, BK = 64, HALF = 128, HTB = HALF * BK * 2  , STAGE_BYTES = 8 * HTB, NXCD = 8, WGM = 8;

__host__ __device__ __forceinline__ int lds_byte(int r, int c) { const int st = (r >> 4) * 2 + (c >> 5), rr = r & 15, cc = c & 31, ob = rr * 64 + cc * 2; return st * 1024 + (ob ^ (((ob >> 9) & 1) << 5)); }
__host__ __device__ __forceinline__ void stage_rc(int b, int& R, int& C) { const int st = b / 1024, sb = b % 1024, swz = sb ^ (((sb >> 9) & 1) << 5); R = (st >> 1) * 16 + swz / 64; C = (st & 1) * 32 + (swz % 64) / 2; }
__host__ __device__ __forceinline__ int perm32(int rho) { const int n = rho >> 4, i = rho & 15; return 8 * (i >> 2) + 4 * n + (i & 3); }

struct Unit { int pm, pn; };
struct Gemm { const bf16_t* A; const bf16_t* Bt; int M, N, K; };

struct StaticOrder {
    int nM, nN, nwg, G, c;
    __host__ __device__ void init(int M, int N, int G_, int c_) { nM = M / BM; nN = N / BM; nwg = nM * nN; G = G_; c = c_; }
    __host__ __device__ bool next(int i, Unit& u) const {
        const long L = (long)i * G + c; if (L >= nwg) return false;
        int wgid = (int)L; { const int q = nwg / NXCD, r = nwg % NXCD, xcd = wgid % NXCD, off = wgid / NXCD; wgid = (xcd < r ? xcd * (q + 1) : r * (q + 1) + (xcd - r) * q) + off; }
        const int nig = WGM * nN, gid = wgid / nig, fm = gid * WGM, gsz = (nM - fm) < WGM ? (nM - fm) : WGM;
        u.pm = fm + ((wgid % nig) % gsz); u.pn = (wgid % nig) / gsz; return true;
    }
    __device__ __forceinline__ void a_ready(const Unit&) const {}
    __device__ __forceinline__ void done(const Unit&) const {}
};

typedef float f32x2_t __attribute__((ext_vector_type(2))); typedef __bf16 bf16x2_t __attribute__((ext_vector_type(2)));
__device__ __forceinline__ unsigned cvt_pk_bf16(float lo, float hi) { f32x2_t v = {lo, hi}; bf16x2_t b = __builtin_convertvector(v, bf16x2_t); return __builtin_bit_cast(unsigned, b); }

template <class Epi, class Sched, bool ALIGN_EPI = false, bool SP2 = false>
__device__ __forceinline__ void gemm_phase(PG8_LAS unsigned char* lds, const Gemm g, const Sched& S, const Epi& E) {
    int tid_ = threadIdx.x; asm volatile("" : "+v"(tid_));
    const int tid = tid_, wid = __builtin_amdgcn_readfirstlane(tid >> 6), lane = tid & 63, wr = wid >> 2, wc = wid & 3, fr = lane & 15, fq = lane >> 4;
    const int K = g.K, nt = K / BK;
    unsigned voffA[2], voffB[2];
#pragma unroll
    for (int i = 0; i < 2; ++i) { int R, C; stage_rc(tid * 16 + i * 8192, R, C); const int Rb = Epi::PERM ? ((R & ~31) + perm32(R & 31)) : R;
        voffA[i] = (unsigned)(R * K + C) * 2u; voffB[i] = (unsigned)(Rb * K + C) * 2u; }
    const size_t kstep = (size_t)(BK * 2);
    const size_t hstep = (size_t)HALF * K * 2;
    const size_t tstep = 2 * hstep;
    const unsigned ldsw = (unsigned)wid * 1024u;
    const int aoff = lds_byte(wr * 64 + fr, fq * 8), boff = lds_byte(wc * 32 + fr, fq * 8);
#define PG8_SA(b, h) (((b) * 2 + (h)) * HTB)
#define PG8_SB(b, h) ((4 + (b) * 2 + (h)) * HTB)
#define PG8_STAGE(bufoff, gbase, voff) do { _Pragma("unroll") for (int _i = 0; _i < 2; ++_i) \
        __builtin_amdgcn_global_load_lds((const unsigned*)((const char*)(gbase) + (voff)[_i]), (PG8_LAS unsigned*)(lds + (bufoff) + ldsw + _i * 8192), 16, 0, 0); } while (0)
#define PG8_LDA(dst, b, h) do { _Pragma("unroll") for (int m = 0; m < 4; ++m) _Pragma("unroll") for (int k = 0; k < 2; ++k) dst[m][k] = *(const PG8_LAS bf16x8*)(lds + PG8_SA(b, h) + aoff + m * 2048 + k * 1024); } while (0)
#define PG8_LDB(dst, b, h) do { _Pragma("unroll") for (int n = 0; n < 2; ++n) _Pragma("unroll") for (int k = 0; k < 2; ++k) dst[n][k] = *(const PG8_LAS bf16x8*)(lds + PG8_SB(b, h) + boff + n * 2048 + k * 1024); } while (0)
#define PG8_MMA(ai, bj, At, Bt) do { __builtin_amdgcn_s_setprio(1); _Pragma("unroll") for (int m = 0; m < 4; ++m) _Pragma("unroll") for (int n = 0; n < 2; ++n) _Pragma("unroll") for (int k = 0; k < 2; ++k) \
        acc[ai][bj][m][n] = __builtin_amdgcn_mfma_f32_16x16x32_bf16(Bt[n][k], At[m][k], acc[ai][bj][m][n], 0, 0, 0); __builtin_amdgcn_s_setprio(0); } while (0)
#define PG8_WAIT_V(n) asm volatile("s_waitcnt vmcnt(" #n ")" ::: "memory")
#define PG8_WAIT_L(n) asm volatile("s_waitcnt lgkmcnt(" #n ")" ::: "memory")
#define PG8_BAR __builtin_amdgcn_s_barrier()
#define PG8_SCHED __builtin_amdgcn_sched_barrier(0)
    Unit cur, nxt; int ui = 0;
    if (!S.next(0, cur)) return;
    f32x4 acc[2][2][4][2];
#pragma unroll
    for (int a = 0; a < 2; ++a)
#pragma unroll
        for (int b = 0; b < 2; ++b)
#pragma unroll
            for (int m = 0; m < 4; ++m)
#pragma unroll
                for (int n = 0; n < 2; ++n) acc[a][b][m][n] = (f32x4){0.f, 0.f, 0.f, 0.f};
    bf16x8 At[4][2], B0[2][2], B1[2][2];
    const char* cA = (const char*)g.A + (size_t)cur.pm * tstep; const char* cB = (const char*)g.Bt + (size_t)cur.pn * tstep;
    S.a_ready(cur);
    if constexpr (SP2) {
        PG8_STAGE(PG8_SB(0, 0), cB, voffB); PG8_STAGE(PG8_SB(0, 1), cB + hstep, voffB); PG8_STAGE(PG8_SA(0, 0), cA, voffA); PG8_STAGE(PG8_SA(0, 1), cA + hstep, voffA);
        if (wr == 1) PG8_BAR;
        PG8_WAIT_V(2); PG8_BAR;
        PG8_STAGE(PG8_SB(1, 0), cB + kstep, voffB); PG8_STAGE(PG8_SA(1, 0), cA + kstep, voffA); PG8_STAGE(PG8_SB(1, 1), cB + hstep + kstep, voffB);
        PG8_WAIT_V(6); PG8_BAR;
    } else {
        PG8_STAGE(PG8_SB(0, 0), cB, voffB); PG8_STAGE(PG8_SA(0, 0), cA, voffA); PG8_STAGE(PG8_SB(0, 1), cB + hstep, voffB); PG8_STAGE(PG8_SA(0, 1), cA + hstep, voffA);
        if (wr == 1) PG8_BAR;
        PG8_WAIT_V(4); PG8_BAR;
        PG8_STAGE(PG8_SB(1, 0), cB + kstep, voffB); PG8_STAGE(PG8_SA(1, 0), cA + kstep, voffA); PG8_STAGE(PG8_SB(1, 1), cB + hstep + kstep, voffB);
        PG8_WAIT_V(6); PG8_BAR;
    }
    for (;;) {
        const bool has_next = S.next(ui + 1, nxt);
        const char* nA = has_next ? (const char*)g.A + (size_t)nxt.pm * tstep : cA; const char* nB = has_next ? (const char*)g.Bt + (size_t)nxt.pn * tstep : cB;
        for (int t = 0; t < nt; t += 2) {
            const bool last = (t == nt - 2);
            const char* a1 = cA + (size_t)(t + 1) * kstep;
            const char* a2 = last ? nA : cA + (size_t)(t + 2) * kstep; const char* b2 = last ? nB : cB + (size_t)(t + 2) * kstep;
            const char* a3 = a2 + kstep; const char* b3 = b2 + kstep;
            if (last && has_next) S.a_ready(nxt);
            if constexpr (SP2) {
            PG8_LDB(B0, 0, 0); PG8_LDB(B1, 0, 1); PG8_SCHED; PG8_LDA(At, 0, 0); PG8_STAGE(PG8_SA(1, 1), a1 + hstep, voffA);
            PG8_WAIT_V(8); PG8_WAIT_L(0); PG8_BAR; PG8_MMA(0, 0, At, B0); PG8_MMA(0, 1, At, B1); PG8_BAR; PG8_SCHED;
            PG8_LDA(At, 0, 1); PG8_STAGE(PG8_SB(0, 0), b2, voffB); PG8_STAGE(PG8_SB(0, 1), b2 + hstep, voffB); PG8_STAGE(PG8_SA(0, 0), a2, voffA);
            PG8_WAIT_V(8); PG8_WAIT_L(0); PG8_BAR; PG8_MMA(1, 0, At, B0); PG8_MMA(1, 1, At, B1); PG8_BAR; PG8_SCHED;
            PG8_LDB(B0, 1, 0); PG8_LDB(B1, 1, 1); PG8_SCHED; PG8_LDA(At, 1, 0); PG8_STAGE(PG8_SA(0, 1), a2 + hstep, voffA);
            PG8_WAIT_V(8); PG8_WAIT_L(0); PG8_BAR; PG8_MMA(0, 0, At, B0); PG8_MMA(0, 1, At, B1); PG8_BAR; PG8_SCHED;
            PG8_LDA(At, 1, 1); PG8_STAGE(PG8_SB(1, 0), b3, voffB); PG8_STAGE(PG8_SB(1, 1), b3 + hstep, voffB); PG8_STAGE(PG8_SA(1, 0), a3, voffA);
            PG8_WAIT_V(8); PG8_WAIT_L(0); PG8_BAR; PG8_MMA(1, 0, At, B0); PG8_MMA(1, 1, At, B1); PG8_BAR; PG8_SCHED;
            } else {
            PG8_LDB(B0, 0, 0); PG8_SCHED; PG8_LDA(At, 0, 0); PG8_STAGE(PG8_SA(1, 1), a1 + hstep, voffA);
            PG8_WAIT_L(8); PG8_BAR; PG8_WAIT_L(0); PG8_MMA(0, 0, At, B0); PG8_BAR; PG8_SCHED;
            PG8_LDB(B1, 0, 1); PG8_STAGE(PG8_SB(0, 0), b2, voffB);
            PG8_BAR; PG8_WAIT_L(0); PG8_MMA(0, 1, At, B1); PG8_BAR;
            PG8_LDA(At, 0, 1); PG8_STAGE(PG8_SA(0, 0), a2, voffA);
            PG8_BAR; PG8_WAIT_L(0); PG8_MMA(1, 0, At, B0); PG8_BAR; PG8_SCHED;
            PG8_STAGE(PG8_SB(0, 1), b2 + hstep, voffB);
            PG8_WAIT_V(6); PG8_BAR; PG8_MMA(1, 1, At, B1); PG8_BAR;
            PG8_LDB(B0, 1, 0); PG8_SCHED; PG8_LDA(At, 1, 0); PG8_STAGE(PG8_SA(0, 1), a2 + hstep, voffA);
            PG8_WAIT_L(8); PG8_BAR; PG8_WAIT_L(0); PG8_MMA(0, 0, At, B0); PG8_BAR; PG8_SCHED;
            PG8_LDB(B1, 1, 1); PG8_STAGE(PG8_SB(1, 0), b3, voffB);
            PG8_BAR; PG8_WAIT_L(0); PG8_MMA(0, 1, At, B1); PG8_BAR;
            PG8_LDA(At, 1, 1); PG8_STAGE(PG8_SA(1, 0), a3, voffA);
            PG8_BAR; PG8_WAIT_L(0); PG8_MMA(1, 0, At, B0); PG8_BAR; PG8_SCHED;
            PG8_STAGE(PG8_SB(1, 1), b3 + hstep, voffB);
            PG8_WAIT_V(6); PG8_BAR; PG8_MMA(1, 1, At, B1); PG8_BAR;
            }
        }
        if constexpr (ALIGN_EPI) { if (wr == 0) PG8_BAR; }
        if constexpr (!Epi::AFTER_DRAIN) { E(acc, cur, wr, wc, fr, fq); S.done(cur); }
        if (!has_next) break;
#pragma unroll
        for (int a = 0; a < 2; ++a)
#pragma unroll
            for (int b = 0; b < 2; ++b)
#pragma unroll
                for (int m = 0; m < 4; ++m)
#pragma unroll
                    for (int n = 0; n < 2; ++n) acc[a][b][m][n] = (f32x4){0.f, 0.f, 0.f, 0.f};
        cur = nxt; cA = nA; cB = nB; ++ui;
        if constexpr (ALIGN_EPI) { if (wr == 1) PG8_BAR; }
    }
    PG8_WAIT_V(0);
    if constexpr (!ALIGN_EPI) { if (wr == 0) PG8_BAR; }
    PG8_BAR;
    if constexpr (Epi::AFTER_DRAIN) { E.fused(acc, cur, wr, wc, fr, fq, lds, wid, lane); S.done(cur); }
#undef PG8_SA
#undef PG8_SB
#undef PG8_STAGE
#undef PG8_LDA
#undef PG8_LDB
#undef PG8_MMA
#undef PG8_WAIT_V
#undef PG8_WAIT_L
#undef PG8_BAR
#undef PG8_SCHED
}
}

#ifndef MK_PER_PHASE
#define MK_PER_PHASE 0
#endif
#define LAS __attribute__((address_space(3)))
typedef unsigned short bf16;
typedef short bf16x8 __attribute__((ext_vector_type(8)));
typedef float f32x4 __attribute__((ext_vector_type(4)));
typedef unsigned u32x2 __attribute__((ext_vector_type(2)));
typedef unsigned u32x4 __attribute__((ext_vector_type(4)));

constexpr int T = 8192, D = 2048, FF = 5632, SEQ = 4096;
constexpr int MEMT = 512;
constexpr int GLA_N = 5136, GLA_NP = 5376;
constexpr int CONV_N = 5120, CONV_LD = 3584;
constexpr int NITEM = 512;
constexpr float EPS = 1e-6f;
constexpr int NWAVES = 8, NTHR = 512;
constexpr int LDS_BYTES = 147456;

constexpr size_t SZ_FFI = (size_t)2 * FF * D * 2, SZ_FFO = (size_t)D * FF * 2, SZ_GLA = (size_t)GLA_NP * D * 2, SZ_CONV = (size_t)CONV_N * D * 2, SZ_MIX = (size_t)D * D * 2, SZ_KV = (size_t)1024 * D * 2;
constexpr size_t WS_FFI = 0;
constexpr size_t WS_FFO = WS_FFI + 4 * SZ_FFI;
constexpr size_t WS_GLA = WS_FFO + 4 * SZ_FFO;
constexpr size_t WS_CONV = WS_GLA + SZ_GLA;
constexpr size_t WS_MIX = WS_CONV + SZ_CONV;
constexpr size_t WS_KV = WS_MIX + 2 * SZ_MIX;
constexpr size_t WS_MEMN = WS_KV + 2 * SZ_KV;
constexpr size_t WS_KB = WS_MEMN + (size_t)2 * MEMT * D * 2;
constexpr size_t WS_VT = WS_KB + (size_t)2 * 512 * 512 * 2;
constexpr size_t WS_XN = WS_VT + (size_t)2 * 512 * 512 * 2;
constexpr size_t WS_HB = WS_XN + (size_t)T * D * 2;
constexpr size_t WS_Y = WS_HB + (size_t)T * FF * 2;
constexpr size_t WS_P = WS_Y + (size_t)T * D * 4;
constexpr size_t WS_CAT = WS_P + (size_t)T * GLA_NP * 2;
constexpr size_t WS_QT = WS_CAT + (size_t)T * D * 2;
constexpr size_t WS_AM = WS_QT + (size_t)T * 768 * 2;
constexpr size_t WS_UT = WS_AM + (size_t)NITEM * 4096 * 2;
constexpr size_t WS_ST = WS_UT + (size_t)NITEM * 73728 * 2;
constexpr size_t WS_DB = WS_ST + (size_t)NITEM * 73728 * 2;
constexpr size_t WS_CTL = WS_DB + (size_t)NITEM * 192 * 4;
constexpr size_t CTL_BYTES = 65536;
constexpr size_t WS_END = WS_CTL + CTL_BYTES;
constexpr int MISC_OFF = LDS_BYTES - 64;

struct Args {
    const float *x, *mem, *ffn_pre_g, *ffn_w_in, *ffn_w_out, *ffn_post_g, *mix_pre_g, *mix_post_g, *mem_g, *w_mem_kv, *w_mix_out, *gla_w_in, *gla_gate_w2, *gla_gate_b, *gla_head_g, *conv_w_in, *conv_w, *conv_b;
    float* out; unsigned char* ws; int ph_lo, ph_hi;
};

__device__ __forceinline__ float bf2f(bf16 v) { return __uint_as_float(((unsigned)v) << 16); }
__device__ __forceinline__ float bf_lo(unsigned w) { return __uint_as_float(w << 16); }
__device__ __forceinline__ float bf_hi(unsigned w) { return __uint_as_float(w & 0xffff0000u); }
__device__ __forceinline__ unsigned pk(float lo, float hi) { return pg8::cvt_pk_bf16(lo, hi); }
__device__ __forceinline__ bf16 f2bf1(float f) { return (bf16)(pg8::cvt_pk_bf16(f, 0.f) & 0xffffu); }
__device__ __forceinline__ f32x4 mfma16(bf16x8 a, bf16x8 b, f32x4 c) { return __builtin_amdgcn_mfma_f32_16x16x32_bf16(a, b, c, 0, 0, 0); }
__device__ __forceinline__ float wave_sum(float v) {
#pragma unroll
    for (int o = 1; o < 64; o <<= 1) v += __shfl_xor(v, o);
    return v;
}
__device__ __forceinline__ float silu_f(float g) { return g * __builtin_amdgcn_rcpf(1.f + __builtin_amdgcn_exp2f(-1.44269504f * g)); }
#define LDS_WAIT() asm volatile("s_waitcnt lgkmcnt(0)" ::: "memory")

namespace pg8 {
struct OffOrder : StaticOrder {
    __device__ bool next(int i, Unit& u) const { if (c < 0) return false; return StaticOrder::next(i, u); }
};
struct EpiF32 {
    static constexpr bool PERM = false, AFTER_DRAIN = false;
    float* C; int ldc;
    __device__ __forceinline__ void operator()(const f32x4 (&acc)[2][2][4][2], const Unit& u, int wr, int wc, int fr, int fq) const {
        const int row0 = u.pm * BM + wr * 64 + fr, col0 = u.pn * BM + wc * 32 + 4 * fq;
#pragma unroll
        for (int ai = 0; ai < 2; ++ai)
#pragma unroll
            for (int m = 0; m < 4; ++m) { float* rowp = C + (size_t)(row0 + ai * HALF + m * 16) * ldc + col0;
#pragma unroll
                for (int bj = 0; bj < 2; ++bj)
#pragma unroll
                    for (int n = 0; n < 2; ++n) *(f32x4*)(rowp + bj * HALF + n * 16) = acc[ai][bj][m][n]; }
    }
};
struct EpiPlain {
    static constexpr bool PERM = true, AFTER_DRAIN = false;
    bf16_t* O; int ldc;
    __device__ __forceinline__ void operator()(const f32x4 (&acc)[2][2][4][2], const Unit& u, int wr, int wc, int fr, int fq) const {
        const int row0 = u.pm * BM + wr * 64 + fr, col0 = u.pn * BM + wc * 32 + 8 * fq;
#pragma unroll
        for (int ai = 0; ai < 2; ++ai)
#pragma unroll
            for (int m = 0; m < 4; ++m) { bf16_t* rowp = O + (size_t)(row0 + ai * HALF + m * 16) * ldc + col0;
#pragma unroll
                for (int bj = 0; bj < 2; ++bj) { const f32x4 v0 = acc[ai][bj][m][0], v1 = acc[ai][bj][m][1];
                    u32x4 w; w.x = cvt_pk_bf16(v0[0], v0[1]); w.y = cvt_pk_bf16(v0[2], v0[3]); w.z = cvt_pk_bf16(v1[0], v1[1]); w.w = cvt_pk_bf16(v1[2], v1[3]);
                    *(u32x4*)(rowp + bj * HALF) = w; } }
    }
};
struct EpiGlu {
    static constexpr bool PERM = true, AFTER_DRAIN = false;
    bf16_t* O; int ldc;
    __device__ __forceinline__ void operator()(const f32x4 (&acc)[2][2][4][2], const Unit& u, int wr, int wc, int fr, int fq) const {
        const int row0 = u.pm * BM + wr * 64 + fr, col0 = u.pn * HALF + wc * 32 + 8 * fq;
#pragma unroll
        for (int ai = 0; ai < 2; ++ai)
#pragma unroll
            for (int m = 0; m < 4; ++m) { bf16_t* rowp = O + (size_t)(row0 + ai * HALF + m * 16) * ldc + col0;
                const f32x4 g0 = acc[ai][0][m][0], g1 = acc[ai][0][m][1], u0 = acc[ai][1][m][0], u1 = acc[ai][1][m][1];
                float h[8];
#pragma unroll
                for (int j = 0; j < 4; ++j) { h[j] = g0[j] * __builtin_amdgcn_rcpf(1.f + __builtin_amdgcn_exp2f(-1.44269504f * g0[j])) * u0[j];
                                              h[4 + j] = g1[j] * __builtin_amdgcn_rcpf(1.f + __builtin_amdgcn_exp2f(-1.44269504f * g1[j])) * u1[j]; }
                u32x4 w; w.x = cvt_pk_bf16(h[0], h[1]); w.y = cvt_pk_bf16(h[2], h[3]); w.z = cvt_pk_bf16(h[4], h[5]); w.w = cvt_pk_bf16(h[6], h[7]);
                *(u32x4*)rowp = w; }
    }
};
struct EpiConv {
    static constexpr bool PERM = true, AFTER_DRAIN = false;
    bf16_t* O; int ldc;
    __device__ __forceinline__ void operator()(const f32x4 (&acc)[2][2][4][2], const Unit& u, int wr, int wc, int fr, int fq) const {
        const int row0 = u.pm * BM + wr * 64 + fr;
        if (u.pn >= 6 && u.pn < 18) {
            const int col0 = 1536 + (u.pn - 6) * HALF + wc * 32 + 8 * fq;
#pragma unroll
            for (int ai = 0; ai < 2; ++ai)
#pragma unroll
                for (int m = 0; m < 4; ++m) { bf16_t* rowp = O + (size_t)(row0 + ai * HALF + m * 16) * ldc + col0;
                    const f32x4 v0 = acc[ai][0][m][0] * acc[ai][1][m][0], v1 = acc[ai][0][m][1] * acc[ai][1][m][1];
                    u32x4 w; w.x = cvt_pk_bf16(v0[0], v0[1]); w.y = cvt_pk_bf16(v0[2], v0[3]); w.z = cvt_pk_bf16(v1[0], v1[1]); w.w = cvt_pk_bf16(v1[2], v1[3]);
                    *(u32x4*)rowp = w; }
        } else {
            const int col0 = (u.pn < 6 ? u.pn * BM : 3072 + (u.pn - 18) * BM) + wc * 32 + 8 * fq;
#pragma unroll
            for (int ai = 0; ai < 2; ++ai)
#pragma unroll
                for (int m = 0; m < 4; ++m) { bf16_t* rowp = O + (size_t)(row0 + ai * HALF + m * 16) * ldc + col0;
#pragma unroll
                    for (int bj = 0; bj < 2; ++bj) { const f32x4 v0 = acc[ai][bj][m][0], v1 = acc[ai][bj][m][1];
                        u32x4 w; w.x = cvt_pk_bf16(v0[0], v0[1]); w.y = cvt_pk_bf16(v0[2], v0[3]); w.z = cvt_pk_bf16(v1[0], v1[1]); w.w = cvt_pk_bf16(v1[2], v1[3]);
                        *(u32x4*)(rowp + bj * HALF) = w; } }
        }
    }
};
}

__device__ __forceinline__ int rowmap(int kind, int n) {
    if (kind == 1) { if (n < FF) return 256 * (n >> 7) + (n & 127); n -= FF; return 256 * (n >> 7) + 128 + (n & 127); }
    if (kind == 2) { if (n < 4608) return n; if (n < 4624) return 5120 + (n - 4608); return n - 16; }
    if (kind == 3) { if (n < 1536 || n >= 4608) return n; if (n < 3072) { n -= 1536; return 1536 + 256 * (n >> 7) + (n & 127); }
                     n -= 3072; return 1536 + 256 * (n >> 7) + 128 + (n & 127); }
    return n;
}
__device__ __forceinline__ void transpose_item(const float* __restrict__ W, int K, int N, bf16* __restrict__ WT, int kind, int item, int lane) {
    const int nblk = (N + 127) >> 7, kb = item / nblk, nb = item - kb * nblk, k0 = 64 * kb + 32 * (lane >> 5), n = 128 * nb + 4 * (lane & 31);
    if (n >= N) return;
    const float* src = W + (size_t)k0 * N + n;
    bf16* dst = WT + (size_t)rowmap(kind, n) * K + k0;
#pragma unroll 1
    for (int kg = 0; kg < 4; kg += 2) {
        f32x4 v[16];
#pragma unroll
        for (int r = 0; r < 16; ++r) v[r] = __builtin_nontemporal_load((const f32x4*)(src + (size_t)(8 * kg + r) * N));
#pragma unroll
        for (int g = 0; g < 2; ++g)
#pragma unroll
            for (int e = 0; e < 4; ++e) { u32x4 o; o.x = pk(v[8 * g][e], v[8 * g + 1][e]); o.y = pk(v[8 * g + 2][e], v[8 * g + 3][e]); o.z = pk(v[8 * g + 4][e], v[8 * g + 5][e]); o.w = pk(v[8 * g + 6][e], v[8 * g + 7][e]);
                *(u32x4*)(dst + (size_t)e * K + 8 * (kg + g)) = o; }
    }
}
__device__ __forceinline__ void norm_row_bf16(const float* __restrict__ xrow, const float* __restrict__ g, bf16* __restrict__ orow, int lane) {
    const f32x4* xr = (const f32x4*)xrow + lane; f32x4 v[8]; float s = 0.f;
#pragma unroll
    for (int j = 0; j < 8; ++j) { v[j] = xr[64 * j]; s += (v[j].x * v[j].x + v[j].y * v[j].y) + (v[j].z * v[j].z + v[j].w * v[j].w); }
    const float r = rsqrtf(wave_sum(s) * (1.f / D) + EPS);
    const f32x4* gr = (const f32x4*)g + lane; u32x2* o8 = (u32x2*)orow + lane;
#pragma unroll
    for (int j = 0; j < 8; ++j) { const f32x4 gg = gr[64 * j]; u32x2 o; o.x = pk(v[j].x * r * gg.x, v[j].y * r * gg.y); o.y = pk(v[j].z * r * gg.z, v[j].w * r * gg.w); o8[64 * j] = o; }
}
__device__ __forceinline__ int mat_items(int i) { return i < 4 ? 2816 : i < 8 ? 1408 : i == 8 ? 1312 : i == 9 ? 1280 : i < 12 ? 512 : 256; }
__device__ __forceinline__ void prologue(const Args& a, LAS unsigned char* lds, int wave, int lane) {
    const int gw = blockIdx.x * NWAVES + wave, NGW = gridDim.x * NWAVES;
    constexpr int NITEMS = 4 * 2816 + 4 * 1408 + 1312 + 1280 + 2 * 512 + 2 * 256;
    for (int it = gw; it < NITEMS; it += NGW) {
        int r = it, i = 0;
        for (; i < 13; ++i) { const int n = mat_items(i); if (r < n) break; r -= n; }
        const float* W; bf16* WT; int K = D, N, kind = 0;
        if (i < 4)       { W = a.ffn_w_in + (size_t)i * D * 2 * FF; WT = (bf16*)(a.ws + WS_FFI + i * SZ_FFI); N = 2 * FF; kind = 1; }
        else if (i < 8)  { W = a.ffn_w_out + (size_t)(i - 4) * FF * D; WT = (bf16*)(a.ws + WS_FFO + (i - 4) * SZ_FFO); K = FF; N = D; }
        else if (i == 8) { W = a.gla_w_in; WT = (bf16*)(a.ws + WS_GLA); N = GLA_N; kind = 2; }
        else if (i == 9) { W = a.conv_w_in; WT = (bf16*)(a.ws + WS_CONV); N = CONV_N; kind = 3; }
        else if (i < 12) { W = a.w_mix_out + (size_t)(i - 10) * D * D; WT = (bf16*)(a.ws + WS_MIX + (i - 10) * SZ_MIX); N = D; }
        else             { W = a.w_mem_kv + (size_t)(i - 12) * D * 1024; WT = (bf16*)(a.ws + WS_KV + (i - 12) * SZ_KV); N = 1024; }
        transpose_item(W, K, N, WT, kind, r, lane);
    }
    { u32x4* z = (u32x4*)(a.ws + WS_GLA + (size_t)GLA_N * D * 2); const int n16 = (GLA_NP - GLA_N) * D * 2 / 16;
      for (int i = gw * 64 + lane; i < n16; i += NGW * 64) z[i] = (u32x4){0u, 0u, 0u, 0u}; }
    for (int m = gw; m < 2 * MEMT; m += NGW) { const int l = m / MEMT, r = m - l * MEMT; norm_row_bf16(a.mem + (size_t)r * D, a.mem_g + l * D, (bf16*)(a.ws + WS_MEMN) + (size_t)m * D, lane); }
    for (int m = gw; m < T; m += NGW) norm_row_bf16(a.x + (size_t)m * D, a.ffn_pre_g, (bf16*)(a.ws + WS_XN) + (size_t)m * D, lane);
}

__device__ __forceinline__ void e_pass(const float* __restrict__ xin, const float* __restrict__ y, float alpha, const float* __restrict__ gpost, float* __restrict__ xout, const float* __restrict__ gnext, bf16* __restrict__ xn, int wave, int lane) {
    const int gw = blockIdx.x * NWAVES + wave, NGW = gridDim.x * NWAVES;
    for (int m = gw; m < T; m += NGW) {
        const f32x4* yr = (const f32x4*)(y + (size_t)m * D) + lane; const f32x4* xr = (const f32x4*)(xin + (size_t)m * D) + lane;
        f32x4 v[8], xv[8]; float s = 0.f;
#pragma unroll
        for (int j = 0; j < 8; ++j) { v[j] = yr[64 * j]; xv[j] = xr[64 * j]; s += (v[j].x * v[j].x + v[j].y * v[j].y) + (v[j].z * v[j].z + v[j].w * v[j].w); }
        const float ry = rsqrtf(wave_sum(s) * (1.f / D) + EPS) * alpha;
        const f32x4* gp = (const f32x4*)gpost + lane; f32x4* xo = (f32x4*)(xout + (size_t)m * D) + lane; float s2 = 0.f;
#pragma unroll
        for (int j = 0; j < 8; ++j) { const f32x4 gg = gp[64 * j]; xv[j] = xv[j] + v[j] * gg * ry; xo[64 * j] = xv[j]; s2 += (xv[j].x * xv[j].x + xv[j].y * xv[j].y) + (xv[j].z * xv[j].z + xv[j].w * xv[j].w); }
        if (gnext) {
            const float rx = rsqrtf(wave_sum(s2) * (1.f / D) + EPS);
            const f32x4* gn = (const f32x4*)gnext + lane; u32x2* o8 = (u32x2*)(xn + (size_t)m * D) + lane;
#pragma unroll
            for (int j = 0; j < 8; ++j) { const f32x4 gg = gn[64 * j]; u32x2 o; o.x = pk(xv[j].x * rx * gg.x, xv[j].y * rx * gg.y); o.y = pk(xv[j].z * rx * gg.z, xv[j].w * rx * gg.w); o8[64 * j] = o; }
        }
    }
}

constexpr int SP_LD = 264;
__device__ __forceinline__ void memattn_item(int item, const bf16* __restrict__ xq, int ldq, int qcol0, const bf16* __restrict__ Kb, const bf16* __restrict__ Vt, bf16* __restrict__ CAT, LAS unsigned char* lds, int w, int lane) {
    LAS bf16* sP = (LAS bf16*)lds;
    LAS float* sMax = (LAS float*)(lds + 64 * SP_LD * 2);
    LAS float* sSum = sMax + 128;
    const int tile = item >> 2, head = item & 3, t0 = tile * 64, b = t0 / SEQ;
    const int l15 = lane & 15, q = lane >> 4, rt = w & 3, half = w >> 2;
    f32x4 s[8];
#pragma unroll
    for (int ct = 0; ct < 8; ++ct) s[ct] = (f32x4){0.f, 0.f, 0.f, 0.f};
    const bf16* qrow = xq + (size_t)(t0 + 16 * rt + l15) * ldq + qcol0 + head * 128 + 8 * q;
    const bf16* krow = Kb + (size_t)(b * 256 + 128 * half + l15) * 512 + head * 128 + 8 * q;
#pragma unroll
    for (int ks = 0; ks < 4; ++ks) {
        const bf16x8 af = *(const bf16x8*)(qrow + 32 * ks);
#pragma unroll
        for (int ct = 0; ct < 8; ++ct) { const bf16x8 bfr = *(const bf16x8*)(krow + (size_t)(16 * ct) * 512 + 32 * ks); s[ct] = mfma16(bfr, af, s[ct]); }
    }
    const float sc = 0.08838834764831845f * 1.44269504f;
    float mx = -3.0e38f;
#pragma unroll
    for (int ct = 0; ct < 8; ++ct) { s[ct] = s[ct] * sc; mx = fmaxf(mx, fmaxf(fmaxf(s[ct][0], s[ct][1]), fmaxf(s[ct][2], s[ct][3]))); }
    mx = fmaxf(mx, __shfl_xor(mx, 16)); mx = fmaxf(mx, __shfl_xor(mx, 32));
    if (q == 0) sMax[half * 64 + 16 * rt + l15] = mx;
    __syncthreads();
    const float m = fmaxf(sMax[16 * rt + l15], sMax[64 + 16 * rt + l15]);
    float sum = 0.f;
#pragma unroll
    for (int ct = 0; ct < 8; ++ct) {
        f32x4 p; p[0] = __builtin_amdgcn_exp2f(s[ct][0] - m); p[1] = __builtin_amdgcn_exp2f(s[ct][1] - m); p[2] = __builtin_amdgcn_exp2f(s[ct][2] - m); p[3] = __builtin_amdgcn_exp2f(s[ct][3] - m);
        sum += (p[0] + p[1]) + (p[2] + p[3]);
        u32x2 o; o.x = pk(p[0], p[1]); o.y = pk(p[2], p[3]);
        *(LAS u32x2*)(sP + (16 * rt + l15) * SP_LD + 128 * half + 16 * ct + 4 * q) = o;
    }
    sum += __shfl_xor(sum, 16); sum += __shfl_xor(sum, 32);
    if (q == 0) sSum[half * 64 + 16 * rt + l15] = sum;
    __syncthreads();
    const float rs = 1.f / (sSum[16 * rt + l15] + sSum[64 + 16 * rt + l15]);
    const int dh = half;
    f32x4 o[4];
#pragma unroll
    for (int ct = 0; ct < 4; ++ct) o[ct] = (f32x4){0.f, 0.f, 0.f, 0.f};
    const bf16* vrow = Vt + (size_t)(head * 128 + 64 * dh + l15) * 512 + b * 256 + 8 * q;
#pragma unroll
    for (int ks = 0; ks < 8; ++ks) {
        const bf16x8 af = *(const LAS bf16x8*)(sP + (16 * rt + l15) * SP_LD + 32 * ks + 8 * q);
#pragma unroll
        for (int ct = 0; ct < 4; ++ct) { const bf16x8 bfr = *(const bf16x8*)(vrow + (size_t)(16 * ct) * 512 + 32 * ks); o[ct] = mfma16(bfr, af, o[ct]); }
    }
    bf16* orow = CAT + (size_t)(t0 + 16 * rt + l15) * D + 1536 + head * 128 + 64 * dh + 4 * q;
#pragma unroll
    for (int ct = 0; ct < 4; ++ct) { u32x2 ov; ov.x = pk(o[ct][0] * rs, o[ct][1] * rs); ov.y = pk(o[ct][2] * rs, o[ct][3] * rs); *(u32x2*)(orow + 16 * ct) = ov; }
}

constexpr int SQ_LD = 200, ST_LD = 72;
constexpr int L_SQ = 0, L_SKIN = 25600, L_SKOT = 51200, L_SVT = 78848, L_SG = 134144, L_STOT = 138240;
__device__ __forceinline__ void load_vT(LAS bf16* sVT, const bf16* __restrict__ P, int t0, int h, int tid) {
#pragma unroll 4
    for (int i = 0; i < 24; ++i) { const int idx = tid + 512 * i, vcol = idx % 384, tp = idx / 384;
        const bf16* src = P + (size_t)(t0 + 2 * tp) * GLA_NP + 1536 + h * 384 + vcol;
        const unsigned lo = src[0], hi = src[GLA_NP];
        *(LAS unsigned*)(sVT + vcol * ST_LD + 2 * tp) = lo | (hi << 16); }
}
__device__ __forceinline__ void gla_a_item(int item, const Args& a, LAS unsigned char* lds, int tid, int w, int lane) {
    const bf16* __restrict__ P = (const bf16*)(a.ws + WS_P);
    bf16* __restrict__ QT = (bf16*)(a.ws + WS_QT); bf16* __restrict__ AM = (bf16*)(a.ws + WS_AM); bf16* __restrict__ UT = (bf16*)(a.ws + WS_UT); float* __restrict__ DB = (float*)(a.ws + WS_DB);
    LAS bf16* sQ = (LAS bf16*)(lds + L_SQ); LAS bf16* sKin = (LAS bf16*)(lds + L_SKIN); LAS bf16* sKoT = (LAS bf16*)(lds + L_SKOT); LAS bf16* sVT = (LAS bf16*)(lds + L_SVT);
    LAS float* sG = (LAS float*)(lds + L_SG); LAS float* sTot = (LAS float*)(lds + L_STOT);
    const int bh = item >> 6, c = item & 63, b = bh >> 2, h = bh & 3, t0 = b * SEQ + 64 * c;
    const int l15 = lane & 15, q = lane >> 4;
#pragma unroll
    for (int i = 0; i < 2; ++i) { const int idx = tid + 512 * i, t = idx >> 4, r = idx & 15; sG[idx] = bf2f(P[(size_t)(t0 + t) * GLA_NP + 5120 + r]); }
    load_vT(sVT, P, t0, h, tid);
    __syncthreads();
    const int kk = tid % 192, half = tid / 192, tb = 32 * half;
    float la[32];
    if (tid < 384) {
        float w2c[16];
#pragma unroll
        for (int r = 0; r < 16; ++r) w2c[r] = a.gla_gate_w2[r * 768 + h * 192 + kk];
        const float bias = a.gla_gate_b[h * 192 + kk];
        float run = 0.f;
#pragma unroll
        for (int i = 0; i < 32; ++i) {
            const LAS f32x4* g4 = (const LAS f32x4*)(sG + (tb + i) * 16);
            float z = bias;
#pragma unroll
            for (int r4 = 0; r4 < 4; ++r4) { const f32x4 gv = g4[r4]; z += (gv.x * w2c[4 * r4] + gv.y * w2c[4 * r4 + 1]) + (gv.z * w2c[4 * r4 + 2] + gv.w * w2c[4 * r4 + 3]); }
            const float ls = fminf(z, 0.f) - __logf(1.f + __expf(-fabsf(z)));
            run += ls * 0.0625f; la[i] = run;
        }
        sTot[half * 192 + kk] = run;
    }
    __syncthreads();
    if (tid < 384) {
        const float tot0 = sTot[kk], tot1 = sTot[192 + kk], last = tot0 + tot1, base = half ? tot0 : 0.f;
        const float qscale = 0.07216878364870323f;
#pragma unroll
        for (int i = 0; i < 32; i += 2) {
            float ko[2];
#pragma unroll
            for (int e = 0; e < 2; ++e) {
                const int t = tb + i + e; const float cum = la[i + e] + base;
                const bf16* prow = P + (size_t)(t0 + t) * GLA_NP + h * 192 + kk;
                const float qv = bf2f(prow[0]) * qscale, kv = bf2f(prow[768]);
                const bf16 qt = f2bf1(qv * __expf(cum));
                sQ[t * SQ_LD + kk] = qt; QT[(size_t)(t0 + t) * 768 + h * 192 + kk] = qt;
                sKin[t * SQ_LD + kk] = f2bf1(kv * __expf(-cum));
                ko[e] = kv * __expf(last - cum);
            }
            *(LAS unsigned*)(sKoT + kk * ST_LD + tb + i) = pk(ko[0], ko[1]);
        }
        if (half == 0) DB[item * 192 + kk] = __expf(last);
    }
    __syncthreads();
    { const int rt = w >> 1;
#pragma unroll
      for (int cc = 0; cc < 2; ++cc) { const int ct = 2 * (w & 1) + cc; f32x4 acc = (f32x4){0.f, 0.f, 0.f, 0.f};
          if (ct <= rt) {
#pragma unroll
              for (int ks = 0; ks < 6; ++ks) { const bf16x8 af = *(const LAS bf16x8*)(sQ + (16 * rt + l15) * SQ_LD + 32 * ks + 8 * q), bfr = *(const LAS bf16x8*)(sKin + (16 * ct + l15) * SQ_LD + 32 * ks + 8 * q); acc = mfma16(bfr, af, acc); }
          }
          const int t = 16 * rt + l15, s0 = 16 * ct + 4 * q;
#pragma unroll
          for (int j = 0; j < 4; ++j) acc[j] = (s0 + j <= t) ? acc[j] : 0.f;
          u32x2 o; o.x = pk(acc[0], acc[1]); o.y = pk(acc[2], acc[3]);
          *(u32x2*)(AM + (size_t)item * 4096 + t * 64 + s0) = o; } }
    { bf16x8 af[3][2];
#pragma unroll
      for (int rt = 0; rt < 3; ++rt)
#pragma unroll
          for (int ks = 0; ks < 2; ++ks) af[rt][ks] = *(const LAS bf16x8*)(sVT + (48 * w + 16 * rt + l15) * ST_LD + 32 * ks + 8 * q);
      bf16* ubase = UT + (size_t)item * 73728 + (size_t)(48 * w + l15) * 192 + 4 * q;
#pragma unroll 4
      for (int ct = 0; ct < 12; ++ct) {
          const bf16x8 b0 = *(const LAS bf16x8*)(sKoT + (16 * ct + l15) * ST_LD + 8 * q), b1 = *(const LAS bf16x8*)(sKoT + (16 * ct + l15) * ST_LD + 32 + 8 * q);
#pragma unroll
          for (int rt = 0; rt < 3; ++rt) { f32x4 acc = (f32x4){0.f, 0.f, 0.f, 0.f}; acc = mfma16(b0, af[rt][0], acc); acc = mfma16(b1, af[rt][1], acc);
              u32x2 o; o.x = pk(acc[0], acc[1]); o.y = pk(acc[2], acc[3]);
              *(u32x2*)(ubase + (size_t)(16 * rt) * 192 + 16 * ct) = o; }
      } }
    __syncthreads();
}
__device__ __forceinline__ void gla_b(const Args& a, int tid) {
    const bf16* __restrict__ UT = (const bf16*)(a.ws + WS_UT); bf16* __restrict__ STt = (bf16*)(a.ws + WS_ST); const float* __restrict__ DB = (const float*)(a.ws + WS_DB);
    for (int wi = blockIdx.x * NTHR + tid; wi < 8 * 9216; wi += gridDim.x * NTHR) {
        const int bh = wi / 9216, e = (wi - bh * 9216) * 8, k0 = e % 192;
        float S[8];
#pragma unroll
        for (int j = 0; j < 8; ++j) S[j] = 0.f;
#pragma unroll 4
        for (int c = 0; c < 64; ++c) {
            const int item = bh * 64 + c; const size_t off = (size_t)item * 73728 + e;
            const u32x4 u = *(const u32x4*)(UT + off);
            const f32x4 d0 = *(const f32x4*)(DB + item * 192 + k0), d1 = *(const f32x4*)(DB + item * 192 + k0 + 4);
            u32x4 so; so.x = pk(S[0], S[1]); so.y = pk(S[2], S[3]); so.z = pk(S[4], S[5]); so.w = pk(S[6], S[7]);
            *(u32x4*)(STt + off) = so;
            S[0] = d0.x * S[0] + bf_lo(u.x); S[1] = d0.y * S[1] + bf_hi(u.x); S[2] = d0.z * S[2] + bf_lo(u.y); S[3] = d0.w * S[3] + bf_hi(u.y);
            S[4] = d1.x * S[4] + bf_lo(u.z); S[5] = d1.y * S[5] + bf_hi(u.z); S[6] = d1.z * S[6] + bf_lo(u.w); S[7] = d1.w * S[7] + bf_hi(u.w);
        }
    }
}
__device__ __forceinline__ void gla_c_item(int item, const Args& a, LAS unsigned char* lds, int tid, int w, int lane) {
    const bf16* __restrict__ P = (const bf16*)(a.ws + WS_P); const bf16* __restrict__ QT = (const bf16*)(a.ws + WS_QT); const bf16* __restrict__ AM = (const bf16*)(a.ws + WS_AM);
    const bf16* __restrict__ STt = (const bf16*)(a.ws + WS_ST); bf16* __restrict__ CAT = (bf16*)(a.ws + WS_CAT);
    LAS bf16* sVT = (LAS bf16*)(lds + L_SVT); LAS float* sSS = (LAS float*)(lds + L_SG);
    const int bh = item >> 6, c = item & 63, b = bh >> 2, h = bh & 3, t0 = b * SEQ + 64 * c;
    const int l15 = lane & 15, q = lane >> 4;
    load_vT(sVT, P, t0, h, tid);
    __syncthreads();
    f32x4 acc[4][3];
#pragma unroll
    for (int rt = 0; rt < 4; ++rt)
#pragma unroll
        for (int ct = 0; ct < 3; ++ct) acc[rt][ct] = (f32x4){0.f, 0.f, 0.f, 0.f};
#pragma unroll
    for (int ks = 0; ks < 2; ++ks) {
        bf16x8 af[4], bfr[3];
#pragma unroll
        for (int rt = 0; rt < 4; ++rt) af[rt] = *(const bf16x8*)(AM + (size_t)item * 4096 + (16 * rt + l15) * 64 + 32 * ks + 8 * q);
#pragma unroll
        for (int ct = 0; ct < 3; ++ct) bfr[ct] = *(const LAS bf16x8*)(sVT + (48 * w + 16 * ct + l15) * ST_LD + 32 * ks + 8 * q);
#pragma unroll
        for (int rt = 0; rt < 4; ++rt)
#pragma unroll
            for (int ct = 0; ct < 3; ++ct) acc[rt][ct] = mfma16(bfr[ct], af[rt], acc[rt][ct]);
    }
#pragma unroll 2
    for (int ks = 0; ks < 6; ++ks) {
        bf16x8 af[4], bfr[3];
#pragma unroll
        for (int rt = 0; rt < 4; ++rt) af[rt] = *(const bf16x8*)(QT + (size_t)(t0 + 16 * rt + l15) * 768 + h * 192 + 32 * ks + 8 * q);
#pragma unroll
        for (int ct = 0; ct < 3; ++ct) bfr[ct] = *(const bf16x8*)(STt + (size_t)item * 73728 + (size_t)(48 * w + 16 * ct + l15) * 192 + 32 * ks + 8 * q);
#pragma unroll
        for (int rt = 0; rt < 4; ++rt)
#pragma unroll
            for (int ct = 0; ct < 3; ++ct) acc[rt][ct] = mfma16(bfr[ct], af[rt], acc[rt][ct]);
    }
#pragma unroll
    for (int rt = 0; rt < 4; ++rt) { float ss = 0.f;
#pragma unroll
        for (int ct = 0; ct < 3; ++ct) ss += (acc[rt][ct][0] * acc[rt][ct][0] + acc[rt][ct][1] * acc[rt][ct][1]) + (acc[rt][ct][2] * acc[rt][ct][2] + acc[rt][ct][3] * acc[rt][ct][3]);
        ss += __shfl_xor(ss, 16); ss += __shfl_xor(ss, 32);
        if (q == 0) sSS[w * 64 + 16 * rt + l15] = ss; }
    __syncthreads();
#pragma unroll
    for (int rt = 0; rt < 4; ++rt) { float tot = 0.f;
#pragma unroll
        for (int ww = 0; ww < 8; ++ww) tot += sSS[ww * 64 + 16 * rt + l15];
        const float rinv = rsqrtf(tot * (1.f / 384.f) + EPS);
        const int t = t0 + 16 * rt + l15;
#pragma unroll
        for (int ct = 0; ct < 3; ++ct) { const int vcol = 48 * w + 16 * ct + 4 * q;
            const f32x4 hg = *(const f32x4*)(a.gla_head_g + vcol);
            const u32x2 rr = *(const u32x2*)(P + (size_t)t * GLA_NP + 3072 + h * 384 + vcol);
            const float r0 = bf_lo(rr.x), r1 = bf_hi(rr.x), r2 = bf_lo(rr.y), r3 = bf_hi(rr.y);
            u32x2 o; o.x = pk(acc[rt][ct][0] * rinv * hg.x * silu_f(r0), acc[rt][ct][1] * rinv * hg.y * silu_f(r1)); o.y = pk(acc[rt][ct][2] * rinv * hg.z * silu_f(r2), acc[rt][ct][3] * rinv * hg.w * silu_f(r3));
            *(u32x2*)(CAT + (size_t)t * D + h * 384 + vcol) = o; } }
    __syncthreads();
}

__device__ __forceinline__ void conv_pass(const Args& a, int tid) {
    const bf16* __restrict__ Pc = (const bf16*)(a.ws + WS_P); bf16* __restrict__ CAT = (bf16*)(a.ws + WS_CAT);
    for (int wi = blockIdx.x * NTHR + tid; wi < T * 192; wi += gridDim.x * NTHR) {
        const int t = wi / 192, c0 = (wi - t * 192) * 8, tl = t & (SEQ - 1);
        const bf16* row = Pc + (size_t)t * CONV_LD;
        const u32x4 bg = *(const u32x4*)(row + c0), u2 = *(const u32x4*)(row + 1536 + c0);
        u32x4 u1 = (u32x4){0u, 0u, 0u, 0u}, u0 = (u32x4){0u, 0u, 0u, 0u};
        if (tl >= 1) u1 = *(const u32x4*)(row - CONV_LD + 1536 + c0);
        if (tl >= 2) u0 = *(const u32x4*)(row - 2 * CONV_LD + 1536 + c0);
        const unsigned bgw[4] = {bg.x, bg.y, bg.z, bg.w}, u2w[4] = {u2.x, u2.y, u2.z, u2.w}, u1w[4] = {u1.x, u1.y, u1.z, u1.w}, u0w[4] = {u0.x, u0.y, u0.z, u0.w};
        unsigned ow[4];
#pragma unroll
        for (int j = 0; j < 4; ++j) { const int cc = c0 + 2 * j;
            const float ya = a.conv_w[cc] * bf_lo(u0w[j]) + a.conv_w[1536 + cc] * bf_lo(u1w[j]) + a.conv_w[3072 + cc] * bf_lo(u2w[j]) + a.conv_b[cc];
            const float yb = a.conv_w[cc + 1] * bf_hi(u0w[j]) + a.conv_w[1536 + cc + 1] * bf_hi(u1w[j]) + a.conv_w[3072 + cc + 1] * bf_hi(u2w[j]) + a.conv_b[cc + 1];
            ow[j] = pk(bf_lo(bgw[j]) * ya, bf_hi(bgw[j]) * yb); }
        *(u32x4*)(CAT + (size_t)t * D + c0) = (u32x4){ow[0], ow[1], ow[2], ow[3]};
    }
}

#define XB_TMO      128
#define XB_XCNT(j)  (256  + 64 * (j))
#define XB_XSUB(j)  (1280 + 64 * (j))
#define XB_XGEN(j)  (2304 + 64 * (j))
#define XB_TOP      3328
#define XB_TOPGEN   3392
#define XCD_BAR_WORDS 3456
#define XB_SPIN_CAP (1u << 18)

__device__ __forceinline__ unsigned xb_ld(unsigned* p)              { return __hip_atomic_load(p, __ATOMIC_RELAXED, __HIP_MEMORY_SCOPE_AGENT); }
__device__ __forceinline__ unsigned xb_add(unsigned* p, unsigned v) { return __hip_atomic_fetch_add(p, v, __ATOMIC_RELAXED, __HIP_MEMORY_SCOPE_AGENT); }
__device__ __forceinline__ unsigned xb_xcc_id() { return (unsigned)__builtin_amdgcn_s_getreg((3 << 11) | 20) & 0xFu; }
#define XB_SPIN(cond, bar) do { unsigned _sp = 0; while (cond) { __builtin_amdgcn_s_sleep(1); \
    if ((++_sp & 255u) == 0u) { if (xb_ld(&(bar)[XB_TMO])) break; if (_sp > XB_SPIN_CAP) { atomicAdd(&(bar)[XB_TMO], 1u); break; } } } } while (0)

struct XcdBarrier {
    unsigned* bar; unsigned x;
    volatile LAS unsigned* st;
};

__device__ __forceinline__ XcdBarrier xcd_barrier_post(unsigned* bar, volatile LAS unsigned* st) {
    XcdBarrier b; b.bar = bar; b.x = xb_xcc_id(); b.st = st;
    if (threadIdx.x == 0) (void)xb_add(&bar[XB_XCNT(b.x)], 1u);
    return b;
}
__device__ __forceinline__ void xcd_barrier_complete(unsigned* bar, unsigned x, unsigned& nloc, unsigned& nx) {
    const unsigned G = gridDim.x * gridDim.y * gridDim.z;
    unsigned sum, cnt, mine, sp = 0u;
    for (;;) {
        sum = 0u; cnt = 0u; mine = 0u;
#pragma unroll
        for (unsigned j = 0; j < 16; ++j) { const unsigned c = xb_ld(&bar[XB_XCNT(j)]); sum += c; cnt += (c > 0u) ? 1u : 0u; mine = (j == x) ? c : mine; }
        if (sum == G) break;
        __builtin_amdgcn_s_sleep(1);
        if ((++sp & 255u) == 0u) { if (xb_ld(&bar[XB_TMO])) break; if (sp > XB_SPIN_CAP) { atomicAdd(&bar[XB_TMO], 1u); break; } }
    }
    nloc = mine > 0u ? mine : 1u; nx = cnt > 0u ? cnt : 1u;
}

__device__ __forceinline__ void xcd_barrier(const XcdBarrier& b) {
    asm volatile("s_waitcnt vmcnt(0)" ::: "memory");
    __syncthreads();
    if (threadIdx.x == 0) {
        unsigned* bar = b.bar;
        __builtin_amdgcn_s_waitcnt(0);
        unsigned nloc = b.st[0], nx = b.st[1];
        if (nloc == 0u) { xcd_barrier_complete(bar, b.x, nloc, nx); b.st[0] = nloc; b.st[1] = nx; }
        const unsigned old = xb_add(&bar[XB_XSUB(b.x)], 1u);
        const unsigned gen = old / nloc;
        if (old + 1u == (gen + 1u) * nloc) {
            __builtin_amdgcn_fence(__ATOMIC_RELEASE, "agent");
            asm volatile("s_waitcnt vmcnt(0)" ::: "memory");
            const unsigned og = xb_add(&bar[XB_TOP], 1u);
            const unsigned tg = og / nx;
            if (og + 1u == (tg + 1u) * nx) xb_add(&bar[XB_TOPGEN], 1u);
            else XB_SPIN(xb_ld(&bar[XB_TOPGEN]) == tg, bar);
            __builtin_amdgcn_fence(__ATOMIC_ACQUIRE, "agent");
            xb_add(&bar[XB_XGEN(b.x)], 1u);
            asm volatile("s_waitcnt vmcnt(0)" ::: "memory");
        } else {
            XB_SPIN(xb_ld(&bar[XB_XGEN(b.x)]) == gen, bar);
            __builtin_amdgcn_fence(__ATOMIC_ACQUIRE, "agent");
            asm volatile("s_waitcnt vmcnt(0)" ::: "memory");
        }
    }
    __syncthreads();
}


constexpr int PH_PER_LAYER = 12, N_PHASES = 1 + 2 * PH_PER_LAYER;
__global__ void __launch_bounds__(NTHR, 2) mk_fwd(Args a) {
    extern __shared__ __attribute__((aligned(16))) unsigned char lds_raw[];
    LAS unsigned char* lds = (LAS unsigned char*)lds_raw;
    cg::grid_group grid = cg::this_grid();
    const int G = gridDim.x;
    bool first = true;
    if (threadIdx.x < 16) ((LAS unsigned*)(lds + MISC_OFF))[threadIdx.x] = 0u;
    __syncthreads();
    const XcdBarrier bar = xcd_barrier_post((unsigned*)(a.ws + WS_CTL), (volatile LAS unsigned*)(lds + MISC_OFF));
    if (a.ph_lo < 0) grid.sync();
    for (int ph = a.ph_lo; ph < a.ph_hi; ++ph) {
        const int l = (ph - 1) / PH_PER_LAYER, sub = (ph - 1) - l * PH_PER_LAYER;
        if (ph > 0 && l == 1 && (sub == 5 || sub == 6)) continue;
        if (!first) xcd_barrier(bar);
#ifdef EXTRA_SYNC
        if (!first) xcd_barrier(bar);
#endif
        first = false;
#ifdef DUP_MASK
        const int kind_ = (ph == 0) ? 7 : (sub == 0 || sub == 9) ? 0 : (sub == 1 || sub == 10) ? 1 : sub == 7 ? 2 : sub == 3 ? 3 : sub == 4 ? 4 : sub == 5 ? 5 : sub == 6 ? 6 : 8;
        const int nrep_ = ((DUP_MASK >> kind_) & 1) ? 2 : 1;
#pragma unroll 1
        for (int rep_ = 0; rep_ < nrep_; ++rep_) {
#endif
        int tid_ = threadIdx.x; asm volatile("" : "+v"(tid_));
        const int tid = tid_, lane = tid & 63, wave = __builtin_amdgcn_readfirstlane(tid >> 6);
        unsigned char* ws = a.ws; asm volatile("" : "+s"(ws));
        if (ph == 0) {
#ifndef DIS_PRO
 prologue(a, lds, wave, lane);
#endif
        } else if (sub == 0 || sub == 9) {
            const int fi = 2 * l + (sub == 9);
            pg8::Gemm g{(const pg8::bf16_t*)(ws + WS_XN), (const pg8::bf16_t*)(ws + WS_FFI + fi * SZ_FFI), T, 2 * FF, D};
            pg8::StaticOrder S; S.init(T, 2 * FF, G, (int)blockIdx.x);
            pg8::EpiGlu E{(pg8::bf16_t*)(ws + WS_HB), FF};
#ifndef DIS_G1
            pg8::gemm_phase<pg8::EpiGlu, pg8::StaticOrder, true, true>(lds, g, S, E);
#endif
            if (ph == 1) {
#pragma unroll 1
                for (int j = 0; j < 4; ++j) { const int ll = j >> 1, isv = j & 1;
                    const pg8::bf16_t* memn = (const pg8::bf16_t*)(ws + WS_MEMN) + (size_t)ll * MEMT * D; const pg8::bf16_t* wkv = (const pg8::bf16_t*)(ws + WS_KV + ll * SZ_KV);
                    pg8::Gemm g2{isv ? wkv + (size_t)512 * D : memn, isv ? memn : wkv, 512, 512, D};
                    pg8::OffOrder S2; S2.init(512, 512, G, (int)blockIdx.x - 128 - 4 * j); if (S2.c >= 4) S2.c = -1;
                    pg8::EpiPlain E2{(pg8::bf16_t*)(ws + (isv ? WS_VT : WS_KB)) + (size_t)ll * 512 * 512, 512};

#ifndef DIS_GKV
                    pg8::gemm_phase<pg8::EpiPlain, pg8::OffOrder, true, true>(lds, g2, S2, E2);
#endif
 }
            }
        } else if (sub == 1 || sub == 10 || sub == 7) {
            const int fi = 2 * l + (sub == 10);
            pg8::Gemm g{(const pg8::bf16_t*)(ws + (sub == 7 ? WS_CAT : WS_HB)), (const pg8::bf16_t*)(ws + (sub == 7 ? WS_MIX + l * SZ_MIX : WS_FFO + fi * SZ_FFO)), T, D, sub == 7 ? D : FF};
            pg8::StaticOrder S; S.init(T, D, G, (int)blockIdx.x);
            pg8::EpiF32 E{(float*)(ws + WS_Y), D};
#ifndef DIS_G2
            pg8::gemm_phase<pg8::EpiF32, pg8::StaticOrder, true, true>(lds, g, S, E);
#endif
        } else if (sub == 2 || sub == 8 || sub == 11) {
            const float* xin = (ph == 3) ? a.x : a.out;
            const float alpha = (sub == 8) ? 1.f : 0.5f;
            const float* gpost = (sub == 8) ? a.mix_post_g + l * D : a.ffn_post_g + (2 * l + (sub == 11)) * D;
            const float* gnext = (sub == 2) ? a.mix_pre_g + l * D : (sub == 8) ? a.ffn_pre_g + (2 * l + 1) * D : (l == 0 ? a.ffn_pre_g + 2 * D : nullptr);
#ifndef DIS_E
            e_pass(xin, (const float*)(ws + WS_Y), alpha, gpost, a.out, gnext, (bf16*)(ws + WS_XN), wave, lane);
#endif
        } else if (sub == 3) {
            if (l == 0) {
                pg8::Gemm g{(const pg8::bf16_t*)(ws + WS_XN), (const pg8::bf16_t*)(ws + WS_GLA), T, GLA_NP, D};
                pg8::StaticOrder S; S.init(T, GLA_NP, G, (int)blockIdx.x);
                pg8::EpiPlain E{(pg8::bf16_t*)(ws + WS_P), GLA_NP};
#ifndef DIS_GGLA
                pg8::gemm_phase<pg8::EpiPlain, pg8::StaticOrder, true, true>(lds, g, S, E);
#endif
            } else {
                pg8::Gemm g{(const pg8::bf16_t*)(ws + WS_XN), (const pg8::bf16_t*)(ws + WS_CONV), T, CONV_N, D};
                pg8::StaticOrder S; S.init(T, CONV_N, G, (int)blockIdx.x);
                pg8::EpiConv E{(pg8::bf16_t*)(ws + WS_P), CONV_LD};
#ifndef DIS_GCONV
                pg8::gemm_phase<pg8::EpiConv, pg8::StaticOrder, true, true>(lds, g, S, E);
#endif
            }
        } else if (sub == 4) {
            if (l == 0) {
#ifndef DIS_GLAA
 for (int it = blockIdx.x; it < NITEM; it += G) gla_a_item(it, a, lds, tid, wave, lane);
#endif
 }
            else {
#ifndef DIS_CONV
 conv_pass(a, tid);
#endif
 }
            const bf16* Kb = (const bf16*)(ws + WS_KB) + (size_t)l * 512 * 512; const bf16* Vt = (const bf16*)(ws + WS_VT) + (size_t)l * 512 * 512;

#ifndef DIS_MATT
 for (int it = blockIdx.x; it < 512; it += G) { memattn_item(it, (const bf16*)(ws + WS_P), l == 0 ? GLA_NP : CONV_LD, l == 0 ? 4608 : 3072, Kb, Vt, (bf16*)(ws + WS_CAT), lds, wave, lane); __syncthreads(); }
#endif
        } else if (sub == 5) {
#ifndef DIS_GLAB
 gla_b(a, tid);
#endif

        } else if (sub == 6) {
#ifndef DIS_GLAC
 for (int it = blockIdx.x; it < NITEM; it += G) gla_c_item(it, a, lds, tid, wave, lane);
#endif
 }
#ifdef DUP_MASK
        }
#endif
    }
#ifdef DIAG_BUF
    {   xcd_barrier(bar);
        const bf16* src = (const bf16*)(a.ws + DIAG_BUF); const size_t n = (size_t)DIAG_N, tot = (size_t)T * D;
        for (size_t i = (size_t)blockIdx.x * NTHR + threadIdx.x; i < tot; i += (size_t)gridDim.x * NTHR) { float s = 0.f; for (size_t j = i; j < n; j += tot) s += bf2f(src[j]); a.out[i] = (fabsf(s) < 1e30f) ? s : 77777.f; }
    }
#endif
}

extern "C" void kernel_launch(void* const* d_in, const int* in_sizes, int n_in, void* d_out, int out_size, void* d_ws, size_t ws_size, hipStream_t stream) {
    static int grid = 0;
    if (grid == 0) {
        if (n_in != 18 || in_sizes[0] != T * D || out_size != T * D || ws_size < WS_END) { fprintf(stderr, "kernel_launch: unexpected shapes / workspace (n_in %d, in0 %d, out %d, ws %zu, need %zu)\n", n_in, n_in > 0 ? in_sizes[0] : -1, out_size, ws_size, (size_t)WS_END); grid = -1; return; }
        int dev = 0, cus = 0, per_cu = 0;
        if (hipGetDevice(&dev) != hipSuccess || hipDeviceGetAttribute(&cus, hipDeviceAttributeMultiprocessorCount, dev) != hipSuccess) { grid = -1; return; }
        if (hipFuncSetAttribute((const void*)mk_fwd, hipFuncAttributeMaxDynamicSharedMemorySize, LDS_BYTES) != hipSuccess) { fprintf(stderr, "kernel_launch: hipFuncSetAttribute failed\n"); grid = -1; return; }
        if (hipOccupancyMaxActiveBlocksPerMultiprocessor(&per_cu, (const void*)mk_fwd, NTHR, LDS_BYTES) != hipSuccess || per_cu < 1) { fprintf(stderr, "kernel_launch: occupancy query says %d\n", per_cu); per_cu = 1; }
        (void)hipGetLastError();
        grid = cus * 1;
        fprintf(stderr, "kernel_launch: grid %d (cus %d, per_cu %d)\n", grid, cus, per_cu);
    }
    if (grid < 0) return;
    Args a{};
    const float** ap = (const float**)&a;
    for (int i = 0; i < 18; ++i) ap[i] = (const float*)d_in[i];
    a.out = (float*)d_out; a.ws = (unsigned char*)d_ws;
    if (hipMemsetAsync((char*)d_ws + WS_CTL, 0, CTL_BYTES, stream) != hipSuccess) { fprintf(stderr, "kernel_launch: memset failed\n"); return; }
#if MK_PER_PHASE
    for (int ph = 0; ph < N_PHASES; ++ph) {
        if (ph > 12 && ((ph - 1) % PH_PER_LAYER == 5 || (ph - 1) % PH_PER_LAYER == 6)) continue;
        a.ph_lo = ph; a.ph_hi = ph + 1;
        hipLaunchKernelGGL(mk_fwd, dim3(grid), dim3(NTHR), LDS_BYTES, stream, a);
    }
#else
#ifdef DIAG_HI
    a.ph_lo = 0; a.ph_hi = DIAG_HI;
#else
    a.ph_lo = 0; a.ph_hi = N_PHASES;
#endif
    void* args[] = {&a};
    hipError_t e = hipLaunchCooperativeKernel((const void*)mk_fwd, dim3(grid), dim3(NTHR), args, LDS_BYTES, stream);
    if (e != hipSuccess) fprintf(stderr, "kernel_launch: cooperative launch failed: %s (grid %d)\n", hipGetErrorString(e), grid);
#endif
}
```
